# Optimizing an MI355X kernel written in HIP

```python
import jax
import jax.numpy as jnp
from jax import lax
import numpy as np

D_MODEL = 1024
BATCH = 2
SEQ = 8192
DEPTH = 4

GRID_W = 64
CTX_LEN = 256

POOL_WINDOWS = (2, 4, 8, 16)
POOL_GROUPS = len(POOL_WINDOWS)
POOL_DIM = D_MODEL // 4
POOL_GROUP_DIM = POOL_DIM // POOL_GROUPS

HG_HEADS = 4
HG_DK = 128
HG_DV = (D_MODEL // 4) // HG_HEADS
HG_QK = HG_HEADS * HG_DK
HG_V = HG_HEADS * HG_DV
HG_CHUNK = 64

MLA_HEADS = 8
MLA_NOPE = 64
MLA_ROPE = 32
MLA_V = (D_MODEL // 2) // MLA_HEADS
MLA_Q_LORA = D_MODEL // 4
MLA_KV_LORA = D_MODEL // 8
MLA_QK = MLA_NOPE + MLA_ROPE
MLA_SCALE = MLA_QK ** -0.5
ROPE_BASE = 10000.0
Q_BLOCK = 128

MIX_DIM = POOL_DIM + HG_V + MLA_HEADS * MLA_V
COL_WIDTHS = (POOL_DIM, HG_QK, HG_QK, HG_QK, HG_V, HG_V, MLA_Q_LORA, MLA_KV_LORA, MLA_ROPE)
IN_DIM = sum(COL_WIDTHS)
COL_SPLITS = tuple(int(s) for s in np.cumsum(COL_WIDTHS)[:-1])

N_GROUPS = 4
EXPERTS_PER_GROUP = 8
N_EXPERTS = N_GROUPS * EXPERTS_PER_GROUP
TOP_K = 2
D_EXPERT = D_MODEL // 2
MOE_BLOCK = 128

ALPHA = (2 * DEPTH) ** 0.25
BETA = (8 * DEPTH) ** -0.25
EPS = 1e-6

kernel_name = "hybrid_pool_hgrn2_mla_hmoe_diffusion"

F32 = jnp.float32


def layer_norm(x):
    xf = x.astype(F32)
    mu = jnp.mean(xf, axis=-1, keepdims=True)
    var = jnp.mean(jnp.square(xf - mu), axis=-1, keepdims=True)
    return (xf - mu) * lax.rsqrt(var + EPS)


def modulate(x, shift, scale):
    return (layer_norm(x) * (1.0 + scale.astype(F32)) + shift.astype(F32)).astype(x.dtype)


def post_norm(x, g, b):
    return (layer_norm(x) * g.astype(F32) + b.astype(F32)).astype(x.dtype)


def rms_norm(x, g):
    xf = x.astype(F32)
    return (xf * lax.rsqrt(jnp.mean(xf * xf, axis=-1, keepdims=True) + EPS) * g.astype(F32)).astype(x.dtype)


def axial_rope_tables(n_tokens):
    rows = n_tokens // GRID_W
    row = jnp.repeat(jnp.arange(rows, dtype=F32), GRID_W)
    col = jnp.tile(jnp.arange(GRID_W, dtype=F32), rows)
    n_freq = MLA_ROPE // 4
    inv_freq = ROPE_BASE ** (-jnp.arange(n_freq, dtype=F32) / n_freq)
    ang = jnp.stack([row[:, None] * inv_freq, col[:, None] * inv_freq], axis=1)
    return jnp.cos(ang), jnp.sin(ang)


def apply_axial_rope(x, cos, sin):
    xr = x.astype(F32).reshape(x.shape[:-1] + (2, 2, MLA_ROPE // 4))
    x1, x2 = xr[..., 0, :], xr[..., 1, :]
    out = jnp.stack([x1 * cos - x2 * sin, x2 * cos + x1 * sin], axis=-2)
    return out.reshape(x.shape).astype(x.dtype)


def multi_scale_pool(u, w_pool, scale):
    n = u.shape[1]
    uf = u.astype(F32)
    cs = jnp.concatenate([jnp.zeros_like(uf[:, :1]), jnp.cumsum(uf, axis=1)], axis=1)
    t = jnp.arange(n)
    outs = []
    for gi, w in enumerate(POOL_WINDOWS):
        lo = jnp.clip(t - w // 2, 0, n)
        hi = jnp.clip(t + w // 2, 0, n)
        sl = slice(gi * POOL_GROUP_DIM, (gi + 1) * POOL_GROUP_DIM)
        csg = cs[:, :, sl]
        mean = (csg[:, hi] - csg[:, lo]) / (hi - lo).astype(F32)[None, :, None]
        outs.append(mean - uf[:, :, sl])
    pooled = jnp.stack(outs, axis=2)
    y = jnp.einsum("bngc,gcd->bngd", pooled, w_pool.astype(F32))
    return (y.reshape(u.shape) * scale.astype(F32)).astype(u.dtype)


def log_forget(z, lb):
    return jnp.logaddexp(jnp.log(lb), jnp.log1p(-lb) + jax.nn.log_sigmoid(z.astype(F32)))


def gla_chunk_scan(q, k, v, logf, s0):
    bsz, n, h, dk = q.shape
    dv = v.shape[-1]
    nc = n // HG_CHUNK

    def to_chunks(a):
        return a.reshape(bsz, nc, HG_CHUNK, h, a.shape[-1]).transpose(1, 0, 3, 2, 4)

    mask = jnp.tril(jnp.ones((HG_CHUNK, HG_CHUNK), dtype=bool))

    def step(S, inp):
        qc, kc, vc, gc = inp
        b = jnp.cumsum(gc, axis=2)
        o_inter = jnp.einsum("bhtd,bhde->bhte", qc * jnp.exp(b), S)
        diff = b[:, :, :, None, :] - b[:, :, None, :, :]
        decay = jnp.exp(jnp.where(mask[:, :, None], diff, -jnp.inf))
        attn = jnp.einsum("bhtd,bhsd,bhtsd->bhts", qc, kc, decay)
        o = o_inter + jnp.einsum("bhts,bhse->bhte", attn, vc)
        b_last = b[:, :, -1, :]
        S = jnp.exp(b_last)[..., None] * S + jnp.einsum(
            "bhsd,bhse->bhde", kc * jnp.exp(b_last[:, :, None, :] - b), vc)
        return S, o

    S, o = lax.scan(step, s0, (to_chunks(q), to_chunks(k), to_chunks(v), to_chunks(logf)))
    o = o.transpose(1, 0, 3, 2, 4).reshape(bsz, n, h, dv)
    return o, S


def hgrn2_prepare(q_pre, z_f, z_b, i_in, lb_f, lb_b):
    bsz, n = q_pre.shape[:2]

    def heads(a, d):
        return a.astype(F32).reshape(bsz, n, HG_HEADS, d)

    q = heads(jax.nn.silu(q_pre.astype(F32)), HG_DK)
    g_f = heads(log_forget(z_f, lb_f), HG_DK)
    g_b = heads(log_forget(z_b, lb_b), HG_DK)
    return q, -jnp.expm1(g_f), g_f, -jnp.expm1(g_b), g_b, heads(i_in, HG_DV)


def hgrn2_bidirectional(q, kf, gf, kb, gb, v, s_fwd, s_bwd):
    def flip(a):
        return a[:, ::-1]

    o_f, s_f = gla_chunk_scan(q, kf, v, gf, s_fwd)
    o_b, s_b = gla_chunk_scan(flip(q), flip(kb), flip(v), flip(gb), s_bwd)
    return o_f + flip(o_b), s_f, s_b


def hgrn2_readout(o, gate, norm_g, dtype):
    o = o * lax.rsqrt(jnp.mean(o * o, axis=-1, keepdims=True) + EPS)
    o = o.reshape(o.shape[0], o.shape[1], HG_V) * norm_g.astype(F32) * jax.nn.silu(gate.astype(F32))
    return o.astype(dtype)


def mla_queries(cq, q_norm_g, w_uq, cos, sin):
    bsz, n = cq.shape[:2]
    q = (rms_norm(cq, q_norm_g) @ w_uq).reshape(bsz, n, MLA_HEADS, MLA_QK)
    q_nope, q_rope = q[..., :MLA_NOPE], q[..., MLA_NOPE:]
    if cos is not None:
        q_rope = apply_axial_rope(q_rope, cos[:, None], sin[:, None])
    return jnp.concatenate([q_nope, q_rope], axis=-1).transpose(0, 2, 1, 3)


def mla_keys_values(ckv, k_rope, kv_norm_g, w_ukv, cos, sin):
    bsz, n = ckv.shape[:2]
    kv = (rms_norm(ckv, kv_norm_g) @ w_ukv).reshape(bsz, n, MLA_HEADS, MLA_NOPE + MLA_V)
    k_nope, v = kv[..., :MLA_NOPE], kv[..., MLA_NOPE:]
    if cos is not None:
        k_rope = apply_axial_rope(k_rope, cos, sin)
    k_rope = jnp.broadcast_to(k_rope[:, :, None, :], (bsz, n, MLA_HEADS, MLA_ROPE))
    k = jnp.concatenate([k_nope, k_rope], axis=-1)
    return k.transpose(0, 2, 1, 3), v.transpose(0, 2, 1, 3)


def softmax_attend(q, k, v):
    s = jnp.einsum("bhqd,bhkd->bhqk", q, k, preferred_element_type=F32) * MLA_SCALE
    p = jax.nn.softmax(s, axis=-1)
    return jnp.einsum("bhqk,bhkd->bhqd", p.astype(v.dtype), v)


def block_attention(q, k, v):
    bsz, h, n, d = q.shape
    nb = n // Q_BLOCK
    qb = jnp.moveaxis(q.reshape(bsz, h, nb, Q_BLOCK, d), 2, 0)
    o = lax.map(lambda blk: softmax_attend(blk, k, v), qb)
    return jnp.moveaxis(o, 0, 2).reshape(bsz, h, n, v.shape[-1])


def merge_heads(o):
    bsz, h, n, d = o.shape
    return o.transpose(0, 2, 1, 3).reshape(bsz, n, h * d)


def token_mixer(h, hc, w_in, pool_w, pool_scale, lb_f, lb_b, hg_norm_g,
                q_norm_g, w_uq, kv_norm_g, w_ukv, w_out, cos, sin, with_ctx):
    bsz = h.shape[0]
    (p_in, hq, hzf, hzb, hin, hg, cq, ckv, kr) = jnp.split(h @ w_in, COL_SPLITS, axis=-1)
    (p_in_c, hq_c, hzf_c, hzb_c, hin_c, hg_c, cq_c, ckv_c, kr_c) = jnp.split(hc @ w_in, COL_SPLITS, axis=-1)

    a_lat = multi_scale_pool(p_in, pool_w, pool_scale)

    lat_in = hgrn2_prepare(hq, hzf, hzb, hin, lb_f, lb_b)
    ctx_in = hgrn2_prepare(hq_c, hzf_c, hzb_c, hin_c, lb_f, lb_b)
    zero = jnp.zeros((bsz, HG_HEADS, HG_DK, HG_DV), F32)
    o_c, s_f, s_b = hgrn2_bidirectional(*ctx_in, zero, zero)
    o_l, _, _ = hgrn2_bidirectional(*lat_in, s_f, s_b)
    b_lat = hgrn2_readout(o_l, hg, hg_norm_g, h.dtype)

    q_l = mla_queries(cq, q_norm_g, w_uq, cos, sin)
    k_l, v_l = mla_keys_values(ckv, kr, kv_norm_g, w_ukv, cos, sin)
    k_c, v_c = mla_keys_values(ckv_c, kr_c, kv_norm_g, w_ukv, None, None)
    k_all = jnp.concatenate([k_l, k_c], axis=2)
    v_all = jnp.concatenate([v_l, v_c], axis=2)
    c_lat = merge_heads(block_attention(q_l, k_all, v_all))

    out_lat = jnp.concatenate([a_lat, b_lat, c_lat], axis=-1) @ w_out
    if not with_ctx:
        return out_lat, None

    a_ctx = multi_scale_pool(p_in_c, pool_w, pool_scale)
    b_ctx = hgrn2_readout(o_c, hg_c, hg_norm_g, hc.dtype)
    q_c = mla_queries(cq_c, q_norm_g, w_uq, None, None)
    c_ctx_out = merge_heads(softmax_attend(q_c, k_c, v_c))
    out_ctx = jnp.concatenate([a_ctx, b_ctx, c_ctx_out], axis=-1) @ w_out
    return out_lat, out_ctx


def hier_moe(h, w_rg, b_rg, w_re, b_re, w1, w3, w2):
    n, d = h.shape
    lg = (h @ w_rg).astype(F32) + b_rg.astype(F32)
    pg = jax.nn.softmax(lg, axis=-1)
    g_sel = jnp.argmax(lg, axis=-1)
    w_g = jnp.take_along_axis(pg, g_sel[:, None], axis=-1)[:, 0]
    le = ((h @ w_re).astype(F32) + b_re.astype(F32)).reshape(n, N_GROUPS, EXPERTS_PER_GROUP)
    le_sel = jnp.take_along_axis(le, g_sel[:, None, None], axis=1)[:, 0]
    top_v, top_i = lax.top_k(le_sel, TOP_K)
    gate = jax.nn.softmax(top_v, axis=-1) * w_g[:, None]
    expert = g_sel[:, None] * EXPERTS_PER_GROUP + top_i

    n_assign = n * TOP_K
    e_flat = expert.reshape(-1).astype(jnp.int32)
    tok = jnp.repeat(jnp.arange(n, dtype=jnp.int32), TOP_K)
    wt = gate.reshape(-1)
    order = jnp.argsort(e_flat)
    e_s, tok_s, w_s = e_flat[order], tok[order], wt[order]
    counts = jnp.bincount(e_flat, length=N_EXPERTS)
    starts = jnp.cumsum(counts) - counts
    pcounts = (counts + MOE_BLOCK - 1) // MOE_BLOCK * MOE_BLOCK
    pends = jnp.cumsum(pcounts)
    pstarts = pends - pcounts
    dest = pstarts[e_s] + jnp.arange(n_assign) - starts[e_s]
    n_rows = (n_assign + N_EXPERTS * (MOE_BLOCK - 1) + MOE_BLOCK - 1) // MOE_BLOCK * MOE_BLOCK
    n_blocks = n_rows // MOE_BLOCK
    row_tok = jnp.full((n_rows,), n, dtype=jnp.int32).at[dest].set(tok_s)
    row_w = jnp.zeros((n_rows,), F32).at[dest].set(w_s)
    block_e = jnp.clip(jnp.searchsorted(pends, jnp.arange(n_blocks) * MOE_BLOCK, side="right"),
                       0, N_EXPERTS - 1)
    hp = jnp.concatenate([h, jnp.zeros((1, d), h.dtype)], axis=0)
    xr = hp[row_tok].reshape(n_blocks, MOE_BLOCK, d)

    def expert_block(args):
        xb, e = args
        return (jax.nn.silu(xb @ w1[e]) * (xb @ w3[e])) @ w2[e]

    y = lax.map(expert_block, (xr, block_e)).reshape(n_rows, d)
    out = jnp.zeros((n + 1, d), F32).at[row_tok].add(y.astype(F32) * row_w[:, None])[:n]
    return out.astype(h.dtype)


def setup_inputs(seed: int = 0) -> dict:
    key = jax.random.key(seed)
    ks = jax.random.split(key, 28)
    D = D_MODEL

    def nrm(k, shape, s):
        return jax.random.normal(k, shape, F32) * s

    return {
        "x": nrm(ks[0], (BATCH, SEQ, D), 1.0),
        "c": nrm(ks[1], (BATCH, D), 1.0),
        "ctx": nrm(ks[2], (BATCH, CTX_LEN, D), 1.0),
        "c_ctx": nrm(ks[3], (D,), 1.0),
        "w_mod": nrm(ks[4], (DEPTH, D, 6 * D), 0.5 * D ** -0.5),
        "b_mod": nrm(ks[5], (DEPTH, 6 * D), 0.01),
        "w_in": nrm(ks[6], (DEPTH, D, IN_DIM), D ** -0.5),
        "pool_w": nrm(ks[7], (DEPTH, POOL_GROUPS, POOL_GROUP_DIM, POOL_GROUP_DIM), POOL_GROUP_DIM ** -0.5),
        "pool_scale": 1.0 + nrm(ks[8], (DEPTH, POOL_DIM), 0.05),
        "hg_lb_logits": nrm(ks[9], (DEPTH, 2, HG_QK), 0.5),
        "hg_norm_g": 1.0 + nrm(ks[10], (DEPTH, HG_V), 0.05),
        "mla_q_norm_g": 1.0 + nrm(ks[11], (DEPTH, MLA_Q_LORA), 0.05),
        "mla_w_uq": nrm(ks[12], (DEPTH, MLA_Q_LORA, MLA_HEADS * MLA_QK), MLA_Q_LORA ** -0.5),
        "mla_kv_norm_g": 1.0 + nrm(ks[13], (DEPTH, MLA_KV_LORA), 0.05),
        "mla_w_ukv": nrm(ks[14], (DEPTH, MLA_KV_LORA, MLA_HEADS * (MLA_NOPE + MLA_V)), MLA_KV_LORA ** -0.5),
        "w_out": nrm(ks[15], (DEPTH, MIX_DIM, D), MIX_DIM ** -0.5 * BETA),
        "ln1_g": 1.0 + nrm(ks[16], (DEPTH, D), 0.05),
        "ln1_b": nrm(ks[17], (DEPTH, D), 0.01),
        "ln2_g": 1.0 + nrm(ks[18], (DEPTH, D), 0.05),
        "ln2_b": nrm(ks[19], (DEPTH, D), 0.01),
        "router_group_w": nrm(ks[20], (DEPTH, D, N_GROUPS), D ** -0.5),
        "router_group_b": nrm(ks[21], (DEPTH, N_GROUPS), 0.01),
        "router_expert_w": nrm(ks[22], (DEPTH, D, N_EXPERTS), D ** -0.5),
        "router_expert_b": nrm(ks[23], (DEPTH, N_EXPERTS), 0.01),
        "expert_w1": nrm(ks[24], (DEPTH, N_EXPERTS, D, D_EXPERT), D ** -0.5),
        "expert_w3": nrm(ks[25], (DEPTH, N_EXPERTS, D, D_EXPERT), D ** -0.5),
        "expert_w2": nrm(ks[26], (DEPTH, N_EXPERTS, D_EXPERT, D), D_EXPERT ** -0.5 * BETA),
    }


def reference(x, c, ctx, c_ctx, w_mod, b_mod, w_in, pool_w, pool_scale, hg_lb_logits, hg_norm_g,
              mla_q_norm_g, mla_w_uq, mla_kv_norm_g, mla_w_ukv, w_out, ln1_g, ln1_b, ln2_g, ln2_b,
              router_group_w, router_group_b, router_expert_w, router_expert_b,
              expert_w1, expert_w3, expert_w2):
    bsz, n_lat, d = x.shape
    n_ctx = ctx.shape[1]
    cos, sin = axial_rope_tables(n_lat)
    lb_all = jnp.cumsum(jax.nn.softmax(hg_lb_logits.astype(F32), axis=0), axis=0)
    lb_all = lb_all - lb_all[0:1]
    c_act = jax.nn.silu(c)
    cc_act = jax.nn.silu(c_ctx)
    xc = ctx
    for l in range(DEPTH):
        with_ctx = l < DEPTH - 1
        mod = c_act @ w_mod[l] + b_mod[l]
        mod_c = cc_act @ w_mod[l] + b_mod[l]
        sh1, sc1, g1, sh2, sc2, g2 = jnp.split(mod[:, None, :], 6, axis=-1)
        sh1c, sc1c, g1c, sh2c, sc2c, g2c = jnp.split(mod_c, 6, axis=-1)

        h = modulate(x, sh1, sc1)
        hc = modulate(xc, sh1c, sc1c)
        m_lat, m_ctx = token_mixer(h, hc, w_in[l], pool_w[l], pool_scale[l], lb_all[l, 0], lb_all[l, 1],
                                   hg_norm_g[l], mla_q_norm_g[l], mla_w_uq[l], mla_kv_norm_g[l],
                                   mla_w_ukv[l], w_out[l], cos, sin, with_ctx)
        x = post_norm(ALPHA * x + g1 * m_lat, ln1_g[l], ln1_b[l])
        h = modulate(x, sh2, sc2)
        if with_ctx:
            xc = post_norm(ALPHA * xc + g1c * m_ctx, ln1_g[l], ln1_b[l])
            hc = modulate(xc, sh2c, sc2c)
            tokens = jnp.concatenate([h.reshape(-1, d), hc.reshape(-1, d)], axis=0)
            y = hier_moe(tokens, router_group_w[l], router_group_b[l], router_expert_w[l],
                         router_expert_b[l], expert_w1[l], expert_w3[l], expert_w2[l])
            y_lat = y[:bsz * n_lat].reshape(bsz, n_lat, d)
            y_ctx = y[bsz * n_lat:].reshape(bsz, n_ctx, d)
            xc = post_norm(ALPHA * xc + g2c * y_ctx, ln2_g[l], ln2_b[l])
        else:
            y_lat = hier_moe(h.reshape(-1, d), router_group_w[l], router_group_b[l], router_expert_w[l],
                             router_expert_b[l], expert_w1[l], expert_w3[l],
                             expert_w2[l]).reshape(bsz, n_lat, d)
        x = post_norm(ALPHA * x + g2 * y_lat, ln2_g[l], ln2_b[l])
    return x
```

```cpp
#include <hip/hip_runtime.h>
#include <cstdio>
#include <cstdint>

#ifndef MK_MULTI
#define MK_MULTI 0
#endif

typedef unsigned short bf16_t;
typedef short bf16x8 __attribute__((ext_vector_type(8)));
typedef short s16x4 __attribute__((ext_vector_type(4)));
typedef float f32x4 __attribute__((ext_vector_type(4)));
typedef float f32x16 __attribute__((ext_vector_type(16)));
typedef unsigned u32x4 __attribute__((ext_vector_type(4)));
typedef unsigned u32x2 __attribute__((ext_vector_type(2)));
#define LAS __attribute__((address_space(3)))
#define DI __device__ __forceinline__

DI unsigned f2bf(float f) { unsigned u = __float_as_uint(f); return (u + 0x7fffu + ((u >> 16) & 1u)) >> 16; }
DI float bf2f(unsigned h) { return __uint_as_float(h << 16); }
DI unsigned cvtpk(float lo, float hi) { unsigned r; asm volatile("v_cvt_pk_bf16_f32 %0, %1, %2" : "=v"(r) : "v"(lo), "v"(hi)); return r; }
DI float silu_f(float x) { return x / (1.f + __expf(-x)); }
DI float wave_sum(float v) {
#pragma unroll
    for (int o = 32; o >= 1; o >>= 1) v += __shfl_xor(v, o);
    return v;
}

constexpr int NLAT = 16384, NCTXT = 512, NTOK = 16896, DM = 1024, SEQ = 8192, CTX = 256, NKEY = 8448;
constexpr int INDIM = 2720, INPAD = 2816;
constexpr int NEXP = 32, DEXP = 512;
constexpr int NSLOT = 41984;
constexpr float EPS = 1e-6f;
constexpr float ALPHA = 1.6817928305074290f;
constexpr int NSEG = 17;

constexpr size_t al256(size_t x) { return (x + 255) / 256 * 256; }
constexpr size_t WS_CTL = 0, CTL_BYTES = 1u << 20;
constexpr size_t WS_MOD = WS_CTL + CTL_BYTES;
constexpr size_t WS_LB = WS_MOD + al256(4 * 3 * 6144 * 4);
constexpr size_t WS_ROPE = WS_LB + al256(4 * 2 * 512 * 4);
constexpr size_t WS_X = WS_ROPE + al256(2 * 8192 * 16 * 4);
constexpr size_t WS_X1 = WS_X + al256((size_t)NTOK * DM * 4);
constexpr size_t WS_H = WS_X1 + al256((size_t)NTOK * DM * 4);
constexpr size_t WS_PA = WS_H + al256((size_t)NTOK * DM * 2);
constexpr size_t WS_QH = WS_PA + al256((size_t)NTOK * 256 * 2);
constexpr size_t WS_GF = WS_QH + al256((size_t)NTOK * 512 * 2);
constexpr size_t WS_GB = WS_GF + al256((size_t)NTOK * 512 * 4);
constexpr size_t WS_VH = WS_GB + al256((size_t)NTOK * 512 * 4);
constexpr size_t WS_GATE = WS_VH + al256((size_t)NTOK * 256 * 2);
constexpr size_t WS_CQKV = WS_GATE + al256((size_t)NTOK * 256 * 2);
constexpr size_t WS_QB = WS_CQKV + al256((size_t)NTOK * 416 * 2);
constexpr size_t WS_KB = WS_QB + al256((size_t)16 * NKEY * 96 * 2);
constexpr size_t WS_VB = WS_KB + al256((size_t)16 * NKEY * 128 * 2);
constexpr size_t WS_MIX = WS_VB + al256((size_t)16 * NKEY * 64 * 2);
constexpr size_t WS_M = WS_MIX + al256((size_t)NTOK * DM * 2);
constexpr size_t WS_OLOC = WS_M + al256((size_t)NTOK * DM * 4);
constexpr size_t WS_QCUM = WS_OLOC + al256((size_t)2 * NTOK * 256 * 4);
constexpr size_t WS_SLOC = WS_QCUM + al256((size_t)2 * NTOK * 512 * 2);
constexpr size_t WS_DTOT = WS_SLOC + al256((size_t)16 * NSEG * 8192 * 4);
constexpr size_t WS_LIST = WS_DTOT + al256((size_t)16 * NSEG * 128 * 4);
constexpr size_t WS_LISTW = WS_LIST + al256((size_t)NEXP * NTOK * 4);
constexpr size_t WS_TOKSLOT = WS_LISTW + al256((size_t)NEXP * NTOK * 4);
constexpr size_t WS_ACT = WS_TOKSLOT + al256((size_t)NTOK * 16);
constexpr size_t WS_Y = WS_ACT + al256((size_t)NSLOT * 512 * 2);
constexpr size_t WS_WIN = WS_Y + al256((size_t)NSLOT * 1024 * 2);
constexpr size_t WS_WOUT = WS_WIN + al256((size_t)INPAD * 1024 * 2);
constexpr size_t WS_WUQ = WS_WOUT + al256((size_t)1024 * 1024 * 2);
constexpr size_t WS_WUKV = WS_WUQ + al256((size_t)768 * 256 * 2);
constexpr size_t WS_W13 = WS_WUKV + al256((size_t)1024 * 128 * 2);
constexpr size_t WS_W2 = WS_W13 + al256((size_t)NEXP * 1024 * 1024 * 2);
constexpr size_t WS_END = WS_W2 + al256((size_t)NEXP * 1024 * 512 * 2);

constexpr int CW_BAR = 4096;
constexpr int CW_CNT = 16384;

constexpr int LDS_MAIN = 147456;
constexpr int LDS_BYTES = LDS_MAIN + 1024;

struct Params {
    const float* in[27];
    float* out;
    unsigned char* ws;
    int s_lo, s_hi;
};
enum { I_X = 0, I_C, I_CTX, I_CCTX, I_WMOD, I_BMOD, I_WIN, I_POOLW, I_POOLS, I_LBLOG, I_HGNG, I_QNG, I_WUQ, I_KVNG, I_WUKV, I_WOUT,
       I_LN1G, I_LN1B, I_LN2G, I_LN2B, I_RGW, I_RGB, I_REW, I_REB, I_EW1, I_EW3, I_EW2 };

#define XB_TMO      128
#define XB_XCNT(j)  (256  + 64 * (j))
#define XB_XSUB(j)  (1280 + 64 * (j))
#define XB_XGEN(j)  (2304 + 64 * (j))
#define XB_TOP      3328
#define XB_TOPGEN   3392
#define XCD_BAR_WORDS 3456
#define XB_SPIN_CAP (1u << 18)

__device__ __forceinline__ unsigned xb_ld(unsigned* p)              { return __hip_atomic_load(p, __ATOMIC_RELAXED, __HIP_MEMORY_SCOPE_AGENT); }
__device__ __forceinline__ unsigned xb_add(unsigned* p, unsigned v) { return __hip_atomic_fetch_add(p, v, __ATOMIC_RELAXED, __HIP_MEMORY_SCOPE_AGENT); }
__device__ __forceinline__ unsigned xb_xcc_id() { return (unsigned)__builtin_amdgcn_s_getreg((3 << 11) | 20) & 0xFu; }
#define XB_SPIN(cond, bar) do { unsigned _sp = 0; while (cond) { __builtin_amdgcn_s_sleep(1); \
    if ((++_sp & 255u) == 0u) { if (xb_ld(&(bar)[XB_TMO])) break; if (_sp > XB_SPIN_CAP) { atomicAdd(&(bar)[XB_TMO], 1u); break; } } } } while (0)

struct XcdBarrier { unsigned* bar; unsigned x; volatile LAS unsigned* st; };

__device__ __forceinline__ XcdBarrier xcd_barrier_post(unsigned* bar, volatile LAS unsigned* st) {
    XcdBarrier b; b.bar = bar; b.x = xb_xcc_id(); b.st = st;
    if (threadIdx.x == 0) (void)xb_add(&bar[XB_XCNT(b.x)], 1u);
    return b;
}
__device__ __forceinline__ void xcd_barrier_complete(unsigned* bar, unsigned x, unsigned& nloc, unsigned& nx) {
    const unsigned G = gridDim.x * gridDim.y * gridDim.z;
    unsigned sum, cnt, mine, sp = 0u;
    for (;;) {
        sum = 0u; cnt = 0u; mine = 0u;
#pragma unroll
        for (unsigned j = 0; j < 16; ++j) { const unsigned c = xb_ld(&bar[XB_XCNT(j)]); sum += c; cnt += (c > 0u) ? 1u : 0u; mine = (j == x) ? c : mine; }
        if (sum == G) break;
        __builtin_amdgcn_s_sleep(1);
        if ((++sp & 255u) == 0u) { if (xb_ld(&bar[XB_TMO])) break; if (sp > XB_SPIN_CAP) { atomicAdd(&bar[XB_TMO], 1u); break; } }
    }
    nloc = mine > 0u ? mine : 1u; nx = cnt > 0u ? cnt : 1u;
}
__device__ __forceinline__ void xcd_barrier(const XcdBarrier& b) {
    asm volatile("s_waitcnt vmcnt(0)" ::: "memory");
    __syncthreads();
    if (threadIdx.x == 0) {
        unsigned* bar = b.bar;
        __builtin_amdgcn_s_waitcnt(0);
        unsigned nloc = b.st[0], nx = b.st[1];
        if (nloc == 0u) { xcd_barrier_complete(bar, b.x, nloc, nx); b.st[0] = nloc; b.st[1] = nx; }
        const unsigned old = xb_add(&bar[XB_XSUB(b.x)], 1u);
        const unsigned gen = old / nloc;
        if (old + 1u == (gen + 1u) * nloc) {
            __builtin_amdgcn_fence(__ATOMIC_RELEASE, "agent");
            asm volatile("s_waitcnt vmcnt(0)" ::: "memory");
            const unsigned og = xb_add(&bar[XB_TOP], 1u);
            const unsigned tg = og / nx;
            if (og + 1u == (tg + 1u) * nx) xb_add(&bar[XB_TOPGEN], 1u);
            else XB_SPIN(xb_ld(&bar[XB_TOPGEN]) == tg, bar);
            __builtin_amdgcn_fence(__ATOMIC_ACQUIRE, "agent");
            xb_add(&bar[XB_XGEN(b.x)], 1u);
            asm volatile("s_waitcnt vmcnt(0)" ::: "memory");
        } else {
            XB_SPIN(xb_ld(&bar[XB_XGEN(b.x)]) == gen, bar);
            __builtin_amdgcn_fence(__ATOMIC_ACQUIRE, "agent");
            asm volatile("s_waitcnt vmcnt(0)" ::: "memory");
        }
    }
    __syncthreads();
}

#define GAS __attribute__((address_space(1)))
typedef GAS const float* fptr_t;
typedef __attribute__((address_space(4))) const fptr_t* kin_t;
struct Frame {
    kin_t in;
    GAS float* out;
    GAS unsigned char* ws;
    LAS unsigned char* lds;
    int tid, lane, wid, G, bid;
};
#define WSP(T, off) ((T*)(GAS T*)(F.ws + (off)))
DI const float* inp(const Frame& F, int k) { return (const float*)F.in[k]; }
#define PHASE_FRAME(Fin) Frame F = (Fin); { int _t = F.tid; asm volatile("" : "+v"(_t)); F.tid = _t; F.lane = _t & 63; F.wid = __builtin_amdgcn_readfirstlane(_t >> 6); \
    asm volatile("" : "+s"(F.ws), "+s"(F.in), "+s"(F.out)); }

DI int row_seq(int row) { return row < NLAT ? (row >> 13) : 2; }
DI const float* x_in_row(const Frame& F, int l, int row) {
    if (l == 0) return row < NLAT ? inp(F, I_X) + (size_t)row * DM : inp(F, I_CTX) + (size_t)(row - NLAT) * DM;
    return WSP(const float, WS_X) + (size_t)row * DM;
}

DI int lds_byte(int r, int c) { const int st = (r >> 4) * 2 + (c >> 5), rr = r & 15, cc = c & 31, ob = rr * 64 + cc * 2; return st * 1024 + (ob ^ (((ob >> 9) & 1) << 5)); }
DI void stage_rc(int b, int& R, int& C) { const int st = b / 1024, sb = b % 1024, swz = sb ^ (((sb >> 9) & 1) << 5); R = (st >> 1) * 16 + swz / 64; C = (st & 1) * 32 + (swz % 64) / 2; }

struct GemmTile {
    const bf16_t* A; int lda; const int* rowidx; int nvalid; long arow0;
    const bf16_t* Bt; int ldb; long brow0;
    int K;
};
constexpr int GT_STAGE = 49152;

template <bool SSQ>
DI void gemm_tile(const Frame& F, const GemmTile& g, f32x4 (&acc)[4][4], float (&ssq)[4]) {
    const int tid = F.tid, wid = F.wid, lane = F.lane, wr = wid >> 1, wc = wid & 1, fr = lane & 15, fq = lane >> 4;
    LAS unsigned char* lds = F.lds;
    long aoff[2][2], boff[2];
#pragma unroll
    for (int i = 0; i < 2; ++i) {
        int R, C; stage_rc(tid * 16 + i * 8192, R, C);
#pragma unroll
        for (int h = 0; h < 2; ++h) {
            const int rr = h * 128 + R;
            long grow;
            if (g.rowidx) grow = (rr < g.nvalid) ? (long)g.rowidx[rr] : 0L; else grow = g.arow0 + rr;
            aoff[h][i] = grow * g.lda + C;
        }
        boff[i] = (g.brow0 + R) * g.ldb + C;
    }
#pragma unroll
    for (int m = 0; m < 4; ++m) {
        ssq[m] = 0.f;
#pragma unroll
        for (int n = 0; n < 4; ++n) acc[m][n] = (f32x4){0.f, 0.f, 0.f, 0.f};
    }
    const unsigned ldsw = (unsigned)wid * 1024u;
    const int a_rd = (wr >> 1) * 16384 + lds_byte((wr & 1) * 64 + fr, fq * 8);
    const int b_rd = 32768 + lds_byte(wc * 64 + fr, fq * 8);
#define GT_ISSUE(t, s) do { _Pragma("unroll") for (int _h = 0; _h < 2; ++_h) _Pragma("unroll") for (int _i = 0; _i < 2; ++_i) \
        __builtin_amdgcn_global_load_lds((const unsigned*)(g.A + aoff[_h][_i] + (t) * 64), (LAS unsigned*)(lds + (s) * GT_STAGE + _h * 16384 + ldsw + _i * 8192), 16, 0, 0); \
        _Pragma("unroll") for (int _i = 0; _i < 2; ++_i) \
        __builtin_amdgcn_global_load_lds((const unsigned*)(g.Bt + boff[_i] + (t) * 64), (LAS unsigned*)(lds + (s) * GT_STAGE + 32768 + ldsw + _i * 8192), 16, 0, 0); } while (0)
    const int nt = g.K >> 6;
    __builtin_amdgcn_s_barrier();
    GT_ISSUE(0, 0);
    for (int t = 0; t < nt; ++t) {
        const int cur = t & 1;
        if (t + 1 < nt) {
            __builtin_amdgcn_s_barrier();
            GT_ISSUE(t + 1, cur ^ 1);
            asm volatile("s_waitcnt vmcnt(6)" ::: "memory");
        } else {
            asm volatile("s_waitcnt vmcnt(0)" ::: "memory");
        }
        __builtin_amdgcn_s_barrier();
        LAS unsigned char* sb = lds + cur * GT_STAGE;
#pragma unroll
        for (int ks = 0; ks < 2; ++ks) {
            bf16x8 af[4], bfr[4];
#pragma unroll
            for (int m = 0; m < 4; ++m) af[m] = *(const LAS bf16x8*)(sb + a_rd + m * 2048 + ks * 1024);
#pragma unroll
            for (int n = 0; n < 4; ++n) bfr[n] = *(const LAS bf16x8*)(sb + b_rd + n * 2048 + ks * 1024);
            if (SSQ) {
#pragma unroll
                for (int m = 0; m < 4; ++m)
#pragma unroll
                    for (int j = 0; j < 8; ++j) { const float v = bf2f((unsigned)(unsigned short)af[m][j]); ssq[m] = fmaf(v, v, ssq[m]); }
            }
#pragma unroll
            for (int m = 0; m < 4; ++m)
#pragma unroll
                for (int n = 0; n < 4; ++n) acc[m][n] = __builtin_amdgcn_mfma_f32_16x16x32_bf16(bfr[n], af[m], acc[m][n], 0, 0, 0);
        }
    }
#undef GT_ISSUE
    if (SSQ) {
#pragma unroll
        for (int m = 0; m < 4; ++m) { ssq[m] += __shfl_xor(ssq[m], 16); ssq[m] += __shfl_xor(ssq[m], 32); }
    }
}

DI void row_load(const float* p, int lane, float (&v)[16]) {
#pragma unroll
    for (int i = 0; i < 4; ++i) { const f32x4 t = *(const f32x4*)(p + lane * 4 + i * 256); v[4 * i] = t[0]; v[4 * i + 1] = t[1]; v[4 * i + 2] = t[2]; v[4 * i + 3] = t[3]; }
}
DI void row_store(float* p, int lane, const float (&v)[16]) {
#pragma unroll
    for (int i = 0; i < 4; ++i) *(f32x4*)(p + lane * 4 + i * 256) = (f32x4){v[4 * i], v[4 * i + 1], v[4 * i + 2], v[4 * i + 3]};
}
DI void row_store_bf16(bf16_t* p, int lane, const float (&v)[16]) {
#pragma unroll
    for (int i = 0; i < 4; ++i) *(u32x2*)(p + lane * 4 + i * 256) = (u32x2){cvtpk(v[4 * i], v[4 * i + 1]), cvtpk(v[4 * i + 2], v[4 * i + 3])};
}
DI void row_ln(float (&v)[16]) {
    float s = 0.f;
#pragma unroll
    for (int i = 0; i < 16; ++i) s += v[i];
    const float mu = wave_sum(s) * (1.f / 1024.f);
    float q = 0.f;
#pragma unroll
    for (int i = 0; i < 16; ++i) { v[i] -= mu; q = fmaf(v[i], v[i], q); }
    const float rs = rsqrtf(wave_sum(q) * (1.f / 1024.f) + EPS);
#pragma unroll
    for (int i = 0; i < 16; ++i) v[i] *= rs;
}

DI void cvt_tile(const Frame& F, const float* src, int ldsrc, int N, int k0, int n0, bf16_t* dst, int lddst, int dmode, const float* scale) {
    LAS float* T = (LAS float*)F.lds;
    const int tid = F.tid;
    {
        const int r = tid >> 4, c4 = (tid & 15) * 4;
#pragma unroll
        for (int hh = 0; hh < 2; ++hh) {
            const int k = r + hh * 32, n = n0 + c4;
            f32x4 v = (f32x4){0.f, 0.f, 0.f, 0.f};
            if (n < N) v = *(const f32x4*)(src + (size_t)(k0 + k) * ldsrc + n);
            if (scale) { const float s = scale[k0 + k]; v = v * s; }
            T[k * 65 + c4 + 0] = v[0]; T[k * 65 + c4 + 1] = v[1]; T[k * 65 + c4 + 2] = v[2]; T[k * 65 + c4 + 3] = v[3];
        }
    }
    __syncthreads();
    {
        const int n = tid >> 3, k8 = (tid & 7) * 8;
        float v[8];
#pragma unroll
        for (int j = 0; j < 8; ++j) v[j] = T[(k8 + j) * 65 + n];
        const int nn = n0 + n;
        const int drow = dmode == 0 ? nn : (32 * (nn >> 4) + (nn & 15) + (dmode == 2 ? 16 : 0));
        *(u32x4*)(dst + (size_t)drow * lddst + k0 + k8) = (u32x4){cvtpk(v[0], v[1]), cvtpk(v[2], v[3]), cvtpk(v[4], v[5]), cvtpk(v[6], v[7])};
    }
    __syncthreads();
}
DI void phase_convert(const Frame& F, int l) {
    constexpr int U_WIN = 16 * 44, U_WOUT = 16 * 16, U_WUQ = 4 * 12, U_WUKV = 2 * 16, U_E = 32 * 16 * 8;
    constexpr int O1 = U_WIN, O2 = O1 + U_WOUT, O3 = O2 + U_WUQ, O4 = O3 + U_WUKV, O5 = O4 + U_E, O6 = O5 + U_E, O7 = O6 + U_E;
    for (int u = F.bid; u < O7; u += F.G) {
        if (u < O1) { const int kt = u / 44, ntl = u % 44; cvt_tile(F, inp(F, I_WIN) + (size_t)l * 1024 * INDIM, INDIM, INDIM, kt * 64, ntl * 64, WSP(bf16_t, WS_WIN), 1024, 0, nullptr); }
        else if (u < O2) { const int v = u - O1, kt = v / 16, ntl = v % 16; cvt_tile(F, inp(F, I_WOUT) + (size_t)l * 1024 * 1024, 1024, 1024, kt * 64, ntl * 64, WSP(bf16_t, WS_WOUT), 1024, 0, nullptr); }
        else if (u < O3) { const int v = u - O2, kt = v / 12, ntl = v % 12; cvt_tile(F, inp(F, I_WUQ) + (size_t)l * 256 * 768, 768, 768, kt * 64, ntl * 64, WSP(bf16_t, WS_WUQ), 256, 0, inp(F, I_QNG) + l * 256); }
        else if (u < O4) { const int v = u - O3, kt = v / 16, ntl = v % 16; cvt_tile(F, inp(F, I_WUKV) + (size_t)l * 128 * 1024, 1024, 1024, kt * 64, ntl * 64, WSP(bf16_t, WS_WUKV), 128, 0, inp(F, I_KVNG) + l * 128); }
        else if (u < O5) { const int v = u - O4, e = v / 128, w = v % 128, kt = w / 8, ntl = w % 8;
            cvt_tile(F, inp(F, I_EW1) + ((size_t)l * NEXP + e) * 1024 * 512, 512, 512, kt * 64, ntl * 64, WSP(bf16_t, WS_W13) + (size_t)e * 1024 * 1024, 1024, 1, nullptr); }
        else if (u < O6) { const int v = u - O5, e = v / 128, w = v % 128, kt = w / 8, ntl = w % 8;
            cvt_tile(F, inp(F, I_EW3) + ((size_t)l * NEXP + e) * 1024 * 512, 512, 512, kt * 64, ntl * 64, WSP(bf16_t, WS_W13) + (size_t)e * 1024 * 1024, 1024, 2, nullptr); }
        else { const int v = u - O6, e = v / 128, w = v % 128, kt = w / 16, ntl = w % 16;
            cvt_tile(F, inp(F, I_EW2) + ((size_t)l * NEXP + e) * 512 * 1024, 1024, 1024, kt * 64, ntl * 64, WSP(bf16_t, WS_W2) + (size_t)e * 1024 * 512, 512, 0, nullptr); }
    }
}

DI void phase_setup(const Frame& Fin) {
    PHASE_FRAME(Fin);
    const int tid = F.tid, lane = F.lane, wid = F.wid;
    {
        LAS float* act = (LAS float*)F.lds;
        LAS float* red = (LAS float*)(F.lds + 12288);
        for (int i = tid; i < 3072; i += 512) { const int s = i >> 10, k = i & 1023; const float v = s < 2 ? inp(F, I_C)[s * 1024 + k] : inp(F, I_CCTX)[k]; act[i] = silu_f(v); }
        __syncthreads();
        for (int u = F.bid; u < 96; u += F.G) {
            const int l = u / 24, cg = u % 24, col = cg * 256 + lane * 4;
            const float* W = inp(F, I_WMOD) + (size_t)l * 1024 * 6144 + col;
            f32x4 a0 = (f32x4){0.f, 0.f, 0.f, 0.f}, a1 = a0, a2 = a0;
            for (int k = wid * 128; k < wid * 128 + 128; ++k) {
                const f32x4 w = *(const f32x4*)(W + (size_t)k * 6144);
                a0 += w * act[k]; a1 += w * act[1024 + k]; a2 += w * act[2048 + k];
            }
#pragma unroll
            for (int j = 0; j < 4; ++j) { red[(wid * 3 + 0) * 256 + lane * 4 + j] = a0[j]; red[(wid * 3 + 1) * 256 + lane * 4 + j] = a1[j]; red[(wid * 3 + 2) * 256 + lane * 4 + j] = a2[j]; }
            __syncthreads();
            for (int i = tid; i < 768; i += 512) {
                const int s = i >> 8, c = i & 255;
                float sum = 0.f;
#pragma unroll
                for (int w = 0; w < 8; ++w) sum += red[(w * 3 + s) * 256 + c];
                WSP(float, WS_MOD)[((size_t)l * 3 + s) * 6144 + cg * 256 + c] = sum + inp(F, I_BMOD)[l * 6144 + cg * 256 + c];
            }
            __syncthreads();
        }
    }
    if (F.bid == F.G - 1) {
        for (int i = tid; i < 1024; i += 512) {
            float z[4], mx = -1e30f;
#pragma unroll
            for (int l = 0; l < 4; ++l) { z[l] = inp(F, I_LBLOG)[l * 1024 + i]; mx = fmaxf(mx, z[l]); }
            float e[4], s = 0.f;
#pragma unroll
            for (int l = 0; l < 4; ++l) { e[l] = expf(z[l] - mx); s += e[l]; }
            float c = 0.f;
#pragma unroll
            for (int l = 0; l < 4; ++l) { if (l > 0) c += e[l] / s; WSP(float, WS_LB)[l * 1024 + i] = c; }
        }
    }
    {
        const int i = F.bid * 512 + tid;
        for (int idx = i; idx < 8192 * 16; idx += F.G * 512) {
            const int t = idx >> 4, ax = (idx >> 3) & 1, f = idx & 7;
            const double fr = f == 0 ? 1.0 : f == 1 ? 0.31622776601683794 : f == 2 ? 0.1 : f == 3 ? 0.031622776601683794 : f == 4 ? 0.01 : f == 5 ? 0.0031622776601683794 : f == 6 ? 0.001 : 0.00031622776601683794;
            const double pos = (double)(ax == 0 ? (t >> 6) : (t & 63));
            const double ang = pos * fr;
            const double n = __builtin_rint(ang * 0.63661977236758134308);
            double r = __builtin_fma(-n, 1.5707963267948966192, ang);
            r = __builtin_fma(-n, 6.123233995736766036e-17, r);
            const double r2 = r * r;
            double sp = 1.0 / 6227020800.0; sp = sp * r2 - 1.0 / 39916800.0; sp = sp * r2 + 1.0 / 362880.0; sp = sp * r2 - 1.0 / 5040.0; sp = sp * r2 + 1.0 / 120.0; sp = sp * r2 - 1.0 / 6.0; sp = sp * r2 + 1.0;
            const double sn = r * sp;
            double cp = -1.0 / 87178291200.0; cp = cp * r2 + 1.0 / 479001600.0; cp = cp * r2 - 1.0 / 3628800.0; cp = cp * r2 + 1.0 / 40320.0; cp = cp * r2 - 1.0 / 720.0; cp = cp * r2 + 1.0 / 24.0; cp = cp * r2 - 0.5; cp = cp * r2 + 1.0;
            const int qd = ((int)n) & 3;
            double cs, ss;
            if (qd == 0) { cs = cp; ss = sn; } else if (qd == 1) { cs = -sn; ss = cp; } else if (qd == 2) { cs = -cp; ss = -sn; } else { cs = sn; ss = -cp; }
            WSP(float, WS_ROPE)[idx] = (float)cs;
            WSP(float, WS_ROPE)[8192 * 16 + idx] = (float)ss;
        }
    }
    phase_convert(F, 0);
}

DI void phase_mod0(const Frame& Fin) {
    PHASE_FRAME(Fin);
    const int lane = F.lane;
    for (int row = F.bid * 8 + F.wid; row < NTOK; row += F.G * 8) {
        float v[16]; row_load(x_in_row(F, 0, row), lane, v); row_ln(v);
        const float* md = WSP(const float, WS_MOD) + (size_t)(0 * 3 + row_seq(row)) * 6144;
        float sh[16], sc[16]; row_load(md, lane, sh); row_load(md + 1024, lane, sc);
#pragma unroll
        for (int i = 0; i < 16; ++i) v[i] = fmaf(v[i], 1.f + sc[i], sh[i]);
        row_store_bf16(WSP(bf16_t, WS_H) + (size_t)row * DM, lane, v);
    }
}

DI float logf_gate(float z, float lb) {
    const float k = (1.f - lb) / (1.f + expf(z));
    return fmaxf((k < 0.5f) ? log1pf(-k) : logf(1.f - k), -80.f);
}
DI void phase_proj(const Frame& Fin, int l) {
    PHASE_FRAME(Fin);
    const int wid = F.wid, lane = F.lane, wr = wid >> 1, wc = wid & 1, fr = lane & 15, fq = lane >> 4;
    const float* lbt = WSP(const float, WS_LB) + l * 1024;
    constexpr int NCT = INPAD / 128;
    for (int u = F.bid; u < 66 * NCT; u += F.G) {
        const int rt = u / NCT, ct = u % NCT;
        GemmTile g; g.A = WSP(const bf16_t, WS_H); g.lda = 1024; g.rowidx = nullptr; g.nvalid = 0; g.arow0 = (long)rt * 256;
        g.Bt = WSP(const bf16_t, WS_WIN); g.ldb = 1024; g.brow0 = (long)ct * 128; g.K = 1024;
        f32x4 acc[4][4]; float ssq[4];
        gemm_tile<false>(F, g, acc, ssq);
        const int c64 = ct * 128 + wc * 64;
        const size_t row0 = (size_t)rt * 256 + wr * 64 + fr;
#define FOR_MN _Pragma("unroll") for (int m = 0; m < 4; ++m) _Pragma("unroll") for (int n = 0; n < 4; ++n)
#define PKV2(v) (u32x2){cvtpk((v)[0], (v)[1]), cvtpk((v)[2], (v)[3])}
        if (c64 < 256) { FOR_MN { const f32x4 v = acc[m][n]; *(u32x2*)(WSP(bf16_t, WS_PA) + (row0 + m * 16) * 256 + c64 + n * 16 + fq * 4) = PKV2(v); } }
        else if (c64 < 768) { FOR_MN { const f32x4 v = acc[m][n]; const f32x4 sv = (f32x4){silu_f(v[0]), silu_f(v[1]), silu_f(v[2]), silu_f(v[3])};
            *(u32x2*)(WSP(bf16_t, WS_QH) + (row0 + m * 16) * 512 + (c64 - 256) + n * 16 + fq * 4) = PKV2(sv); } }
        else if (c64 < 1792) {
            const bool bw = c64 >= 1280; const int cb = c64 - (bw ? 1280 : 768);
            float* Gp = WSP(float, bw ? WS_GB : WS_GF);
            const float* lbp = lbt + (bw ? 512 : 0) + cb + fq * 4;
            FOR_MN { const f32x4 v = acc[m][n]; const f32x4 lb = *(const f32x4*)(lbp + n * 16);
                *(f32x4*)(Gp + (row0 + m * 16) * 512 + cb + n * 16 + fq * 4) = (f32x4){logf_gate(v[0], lb[0]), logf_gate(v[1], lb[1]), logf_gate(v[2], lb[2]), logf_gate(v[3], lb[3])}; } }
        else if (c64 < 2048) { FOR_MN { const f32x4 v = acc[m][n]; *(u32x2*)(WSP(bf16_t, WS_VH) + (row0 + m * 16) * 256 + (c64 - 1792) + n * 16 + fq * 4) = PKV2(v); } }
        else if (c64 < 2304) { FOR_MN { const f32x4 v = acc[m][n]; const f32x4 sv = (f32x4){silu_f(v[0]), silu_f(v[1]), silu_f(v[2]), silu_f(v[3])};
            *(u32x2*)(WSP(bf16_t, WS_GATE) + (row0 + m * 16) * 256 + (c64 - 2048) + n * 16 + fq * 4) = PKV2(sv); } }
        else if (c64 < INDIM) { FOR_MN { const f32x4 v = acc[m][n]; if (c64 + n * 16 < INDIM) *(u32x2*)(WSP(bf16_t, WS_CQKV) + (row0 + m * 16) * 416 + (c64 - 2304) + n * 16 + fq * 4) = PKV2(v); } }
    }
}

DI void hgrn_scan_unit(const Frame& F, int unit) {
    const int lane = F.lane;
    LAS float* sc = (LAS float*)(F.lds + F.wid * 2048);
    const int chain = unit / NSEG, seg = unit % NSEG;
    const int b = chain >> 3, hh = (chain >> 1) & 3, dir = chain & 1;
    const int len = seg == 0 ? 256 : 512;
    const int t0 = seg == 0 ? 0 : (dir == 0 ? (seg - 1) * 512 : SEQ - seg * 512);
    const size_t rowbase = seg == 0 ? (size_t)NLAT + b * CTX : (size_t)b * SEQ;
    const float* G = WSP(const float, dir ? WS_GB : WS_GF);
    const bf16_t* QH = WSP(const bf16_t, WS_QH);
    const bf16_t* VH = WSP(const bf16_t, WS_VH);
    float* OL = WSP(float, WS_OLOC) + (size_t)dir * NTOK * 256;
    bf16_t* QC = WSP(bf16_t, WS_QCUM) + (size_t)dir * NTOK * 512;
    float S[128];
#pragma unroll
    for (int d = 0; d < 128; ++d) S[d] = 0.f;
    float bc0 = 0.f, bc1 = 0.f;
    for (int p = 0; p < len; ++p) {
        const int tok = dir ? (t0 + len - 1 - p) : (t0 + p);
        const size_t row = rowbase + tok;
        const float g0 = G[row * 512 + hh * 128 + lane], g1 = G[row * 512 + hh * 128 + 64 + lane];
        const float q0 = bf2f(QH[row * 512 + hh * 128 + lane]), q1 = bf2f(QH[row * 512 + hh * 128 + 64 + lane]);
        const float v = bf2f(VH[row * 256 + hh * 64 + lane]);
        bc0 += g0; bc1 += g1;
        QC[row * 512 + hh * 128 + lane] = (bf16_t)f2bf(q0 * expf(bc0));
        QC[row * 512 + hh * 128 + 64 + lane] = (bf16_t)f2bf(q1 * expf(bc1));
        asm volatile("s_waitcnt lgkmcnt(0)" ::: "memory");
        sc[lane] = expf(g0); sc[64 + lane] = expf(g1);
        sc[128 + lane] = -expm1f(g0); sc[192 + lane] = -expm1f(g1);
        sc[256 + lane] = q0; sc[320 + lane] = q1;
        asm volatile("s_waitcnt lgkmcnt(0)" ::: "memory");
        float o = 0.f;
#pragma unroll
        for (int d4 = 0; d4 < 32; ++d4) {
            const f32x4 f4 = *(const LAS f32x4*)(sc + d4 * 4), k4 = *(const LAS f32x4*)(sc + 128 + d4 * 4), q4 = *(const LAS f32x4*)(sc + 256 + d4 * 4);
#pragma unroll
            for (int j = 0; j < 4; ++j) { S[d4 * 4 + j] = fmaf(f4[j], S[d4 * 4 + j], k4[j] * v); o = fmaf(q4[j], S[d4 * 4 + j], o); }
        }
        OL[row * 256 + hh * 64 + lane] = o;
    }
    float* SL = WSP(float, WS_SLOC) + ((size_t)chain * NSEG + seg) * 8192;
#pragma unroll
    for (int d = 0; d < 128; ++d) SL[d * 64 + lane] = S[d];
    float* DT = WSP(float, WS_DTOT) + ((size_t)chain * NSEG + seg) * 128;
    DT[lane] = bc0; DT[64 + lane] = bc1;
}

DI void pool_unit(const Frame& F, int l, int u) {
    const int tid = F.tid;
    int b, t0, n; size_t rowbase;
    if (u < 256) { b = u >> 7; t0 = (u & 127) * 64; n = SEQ; rowbase = (size_t)b * SEQ; }
    else { const int uu = u - 256; b = uu >> 2; t0 = (uu & 3) * 64; n = CTX; rowbase = (size_t)NLAT + b * CTX; }
    LAS bf16_t* U = (LAS bf16_t*)F.lds;
    LAS float* PL = (LAS float*)(F.lds + 40960);
    const bf16_t* PA = WSP(const bf16_t, WS_PA);
    __syncthreads();
    for (int i = tid; i < 80 * 32; i += 512) {
        const int r = i >> 5, c8 = (i & 31) * 8, t = t0 - 8 + r;
        u32x4 v = (u32x4){0u, 0u, 0u, 0u};
        if (t >= 0 && t < n) v = *(const u32x4*)(PA + (rowbase + t) * 256 + c8);
        *(LAS u32x4*)(U + r * 256 + c8) = v;
    }
    __syncthreads();
    {
        const int c = tid & 255, th = tid >> 8, gi = c >> 6, half = 1 << gi;
        for (int tt = 0; tt < 32; ++tt) {
            const int t = th * 32 + tt, T = t0 + t;
            const int lo = max(T - half, 0), hi = min(T + half, n);
            float s = 0.f;
            for (int x = lo; x < hi; ++x) s += bf2f(U[(x - t0 + 8) * 256 + c]);
            PL[t * 256 + c] = s / (float)(hi - lo) - bf2f(U[(t + 8) * 256 + c]);
        }
    }
    __syncthreads();
    {
        const int o = tid & 255, th = tid >> 8, gi = o >> 6, d = o & 63;
        const float* W = inp(F, I_POOLW) + ((size_t)l * 4 + gi) * 4096 + d;
        float acc[32];
#pragma unroll
        for (int tt = 0; tt < 32; ++tt) acc[tt] = 0.f;
        for (int c4 = 0; c4 < 16; ++c4) {
            const float w0 = W[(c4 * 4 + 0) * 64], w1 = W[(c4 * 4 + 1) * 64], w2 = W[(c4 * 4 + 2) * 64], w3 = W[(c4 * 4 + 3) * 64];
#pragma unroll
            for (int tt = 0; tt < 32; ++tt) {
                const f32x4 pv = *(const LAS f32x4*)(PL + (th * 32 + tt) * 256 + gi * 64 + c4 * 4);
                acc[tt] = fmaf(pv[0], w0, acc[tt]); acc[tt] = fmaf(pv[1], w1, acc[tt]); acc[tt] = fmaf(pv[2], w2, acc[tt]); acc[tt] = fmaf(pv[3], w3, acc[tt]);
            }
        }
        const float psc = inp(F, I_POOLS)[l * 256 + o];
        bf16_t* MX = WSP(bf16_t, WS_MIX);
#pragma unroll
        for (int tt = 0; tt < 32; ++tt) MX[(rowbase + t0 + th * 32 + tt) * 1024 + o] = (bf16_t)f2bf(acc[tt] * psc);
    }
}

DI void qproj_unit(const Frame& F, int u) {
    const int wid = F.wid, lane = F.lane, wr = wid >> 1, wc = wid & 1, fr = lane & 15, fq = lane >> 4;
    const int rt = u / 6, ct = u % 6;
    GemmTile g; g.A = WSP(const bf16_t, WS_CQKV); g.lda = 416; g.rowidx = nullptr; g.nvalid = 0; g.arow0 = (long)rt * 256;
    g.Bt = WSP(const bf16_t, WS_WUQ); g.ldb = 256; g.brow0 = (long)ct * 128; g.K = 256;
    f32x4 acc[4][4]; float ssq[4];
    gemm_tile<true>(F, g, acc, ssq);
    const float* rc = WSP(const float, WS_ROPE); const float* rs = rc + 8192 * 16;
    bf16_t* QB = WSP(bf16_t, WS_QB);
#pragma unroll
    for (int m = 0; m < 4; ++m) {
        const int row = rt * 256 + wr * 64 + m * 16 + fr;
        const float rn = rsqrtf(ssq[m] * (1.f / 256.f) + EPS);
        int bb, key; bool lat = row < NLAT;
        if (lat) { bb = row >> 13; key = row & 8191; } else { bb = (row - NLAT) >> 8; key = SEQ + ((row - NLAT) & 255); }
#pragma unroll
        for (int n = 0; n < 4; ++n) {
            const int col = ct * 128 + wc * 64 + n * 16, hd = col / 96, dq0 = col - hd * 96;
            f32x4 v = acc[m][n] * rn;
            if (dq0 >= 64) {
                const int ax = (dq0 - 64) >> 4;
                f32x4 pv;
#pragma unroll
                for (int j = 0; j < 4; ++j) pv[j] = __shfl_xor(v[j], 32);
                if (lat) {
                    const int f0 = (fq & 1) * 4;
                    const f32x4 cs = *(const f32x4*)(rc + key * 16 + ax * 8 + f0), sn = *(const f32x4*)(rs + key * 16 + ax * 8 + f0);
                    if (fq < 2) v = v * cs - pv * sn; else v = v * cs + pv * sn;
                }
            }
            *(u32x2*)(QB + (((size_t)bb * 8 + hd) * NKEY + key) * 96 + dq0 + fq * 4) = (u32x2){cvtpk(v[0], v[1]), cvtpk(v[2], v[3])};
        }
    }
}

DI void kvproj_unit(const Frame& F, int u) {
    const int tid = F.tid, wid = F.wid, lane = F.lane, wr = wid >> 1, wc = wid & 1, fr = lane & 15, fq = lane >> 4;
    const int rt = u >> 3, hd = u & 7;
    GemmTile g; g.A = WSP(const bf16_t, WS_CQKV) + 256; g.lda = 416; g.rowidx = nullptr; g.nvalid = 0; g.arow0 = (long)rt * 256;
    g.Bt = WSP(const bf16_t, WS_WUKV); g.ldb = 128; g.brow0 = (long)hd * 128; g.K = 128;
    f32x4 acc[4][4]; float ssq[4];
    gemm_tile<true>(F, g, acc, ssq);
    bf16_t* KB = WSP(bf16_t, WS_KB); bf16_t* VB = WSP(bf16_t, WS_VB);
#pragma unroll
    for (int m = 0; m < 4; ++m) {
        const int row = rt * 256 + wr * 64 + m * 16 + fr;
        const float rn = rsqrtf(ssq[m] * (1.f / 128.f) + EPS);
        int bb, key;
        if (row < NLAT) { bb = row >> 13; key = row & 8191; } else { bb = (row - NLAT) >> 8; key = SEQ + ((row - NLAT) & 255); }
        const size_t kr = ((size_t)bb * 8 + hd) * NKEY + key;
#pragma unroll
        for (int n = 0; n < 4; ++n) {
            const int c = n * 16 + fq * 4;
            const f32x4 v = acc[m][n] * rn;
            const u32x2 pk = (u32x2){cvtpk(v[0], v[1]), cvtpk(v[2], v[3])};
            if (wc == 0) *(u32x2*)(KB + kr * 128 + c) = pk; else *(u32x2*)(VB + kr * 64 + c) = pk;
        }
    }
    {
        const int row = rt * 256 + (tid >> 1), ax = tid & 1;
        const bf16_t* src = WSP(const bf16_t, WS_CQKV) + (size_t)row * 416 + 384 + ax * 16;
        const u32x4 a = *(const u32x4*)src, bq = *(const u32x4*)(src + 8);
        float x1[8], x2[8];
#pragma unroll
        for (int j = 0; j < 4; ++j) { x1[2 * j] = bf2f(a[j] & 0xffffu); x1[2 * j + 1] = bf2f(a[j] >> 16); x2[2 * j] = bf2f(bq[j] & 0xffffu); x2[2 * j + 1] = bf2f(bq[j] >> 16); }
        int bb, key; const bool lat = row < NLAT;
        if (lat) { bb = row >> 13; key = row & 8191; } else { bb = (row - NLAT) >> 8; key = SEQ + ((row - NLAT) & 255); }
        float o1[8], o2[8];
        if (lat) {
            const float* rc = WSP(const float, WS_ROPE) + key * 16 + ax * 8; const float* rs = rc + 8192 * 16;
#pragma unroll
            for (int f = 0; f < 8; ++f) { o1[f] = x1[f] * rc[f] - x2[f] * rs[f]; o2[f] = x2[f] * rc[f] + x1[f] * rs[f]; }
        } else {
#pragma unroll
            for (int f = 0; f < 8; ++f) { o1[f] = x1[f]; o2[f] = x2[f]; }
        }
        bf16_t* dst = KB + (((size_t)bb * 8 + hd) * NKEY + key) * 128;
        *(u32x4*)(dst + 64 + ax * 16) = (u32x4){cvtpk(o1[0], o1[1]), cvtpk(o1[2], o1[3]), cvtpk(o1[4], o1[5]), cvtpk(o1[6], o1[7])};
        *(u32x4*)(dst + 64 + ax * 16 + 8) = (u32x4){cvtpk(o2[0], o2[1]), cvtpk(o2[2], o2[3]), cvtpk(o2[4], o2[5]), cvtpk(o2[6], o2[7])};
        *(u32x4*)(dst + 96 + ax * 16) = (u32x4){0u, 0u, 0u, 0u};
        *(u32x4*)(dst + 96 + ax * 16 + 8) = (u32x4){0u, 0u, 0u, 0u};
    }
}

DI void phase_local(const Frame& Fin, int l) {
    PHASE_FRAME(Fin);
    for (int u = F.bid * 8 + F.wid; u < 16 * NSEG; u += F.G * 8) hgrn_scan_unit(F, u);
    __syncthreads();
    for (int u = F.bid; u < 264; u += F.G) pool_unit(F, l, u);
    __syncthreads();
    for (int u = F.bid; u < 66 * 6; u += F.G) qproj_unit(F, u);
    for (int u = F.bid; u < 66 * 8; u += F.G) kvproj_unit(F, u);
}

constexpr int AT_SHM_V = 64 * 64 * 2, AT_SHM_K = 64 * 128 * 2;
constexpr float AT_SCALE = 0.10206207261596575f;
constexpr float AT_THR = 8.f;
#define KSWZ(row, colB) ((row) * 256 + ((colB) ^ (((row) & 7) << 4)))
#define SBAR() __builtin_amdgcn_sched_barrier(0)
DI int crow(int r, int hi) { return (r & 3) + 8 * (r >> 2) + 4 * hi; }
DI void partialSM(f32x16& p0, f32x16& p1, float& m_reg, float& mn, float& alpha) {
    constexpr float C = AT_SCALE * 1.4426950408889634f;
    float pmax = p0[0];
#pragma unroll
    for (int r = 1; r < 16; ++r) pmax = fmaxf(pmax, p0[r]);
#pragma unroll
    for (int r = 0; r < 16; ++r) pmax = fmaxf(pmax, p1[r]);
    { auto rr = __builtin_amdgcn_permlane32_swap(__float_as_uint(pmax), __float_as_uint(pmax), false, false);
      pmax = fmaxf(__uint_as_float(rr[0]), __uint_as_float(rr[1])); }
    if (__builtin_expect(__all(pmax - m_reg <= AT_THR / AT_SCALE), 1)) { mn = m_reg; alpha = 1.f; }
    else { mn = fmaxf(m_reg, pmax); alpha = __builtin_amdgcn_exp2f((m_reg - mn) * C); m_reg = mn; }
    const float mnC = -mn * C;
#pragma unroll
    for (int r = 0; r < 16; ++r) p0[r] = fmaf(p0[r], C, mnC);
#pragma unroll
    for (int r = 0; r < 16; ++r) p1[r] = fmaf(p1[r], C, mnC);
#pragma unroll
    for (int r = 0; r < 16; ++r) p0[r] = __builtin_amdgcn_exp2f(p0[r]);
}
DI void finishSM(f32x16& p0, f32x16& p1, float alpha, float& l_reg, bf16x8& pa0, bf16x8& pa1, bf16x8& pa2, bf16x8& pa3) {
#pragma unroll
    for (int r = 0; r < 16; ++r) p1[r] = __builtin_amdgcn_exp2f(p1[r]);
    float ps = 0;
#pragma unroll
    for (int r = 0; r < 16; ++r) ps += p0[r];
#pragma unroll
    for (int r = 0; r < 16; ++r) ps += p1[r];
    { auto rr = __builtin_amdgcn_permlane32_swap(__float_as_uint(ps), __float_as_uint(ps), false, false);
      ps = __uint_as_float(rr[0]) + __uint_as_float(rr[1]); }
    l_reg = l_reg * alpha + ps;
#define PK4(P, BASE, OUT) do { unsigned a0 = cvtpk(P[BASE + 0], P[BASE + 1]), a1 = cvtpk(P[BASE + 2], P[BASE + 3]);   \
    unsigned b0 = cvtpk(P[BASE + 4], P[BASE + 5]), b1 = cvtpk(P[BASE + 6], P[BASE + 7]);                              \
    auto r0 = __builtin_amdgcn_permlane32_swap(a0, b0, false, false); auto r1 = __builtin_amdgcn_permlane32_swap(a1, b1, false, false); \
    u32x4 w = {r0[0], r1[0], r0[1], r1[1]}; OUT = __builtin_bit_cast(bf16x8, w); } while (0)
    PK4(p0, 0, pa0); PK4(p0, 8, pa1); PK4(p1, 0, pa2); PK4(p1, 8, pa3);
#undef PK4
}
DI void qkt(f32x16& p0, f32x16& p1, const LAS unsigned char* Ks, const bf16x8* qr, int r32, int hi) {
#pragma unroll
    for (int r = 0; r < 16; ++r) { p0[r] = 0.f; p1[r] = 0.f; }
#pragma unroll
    for (int d0 = 0; d0 < 6; ++d0) { const int cb = (d0 * 16 + hi * 8) * 2;
        const bf16x8 b0 = *(const LAS bf16x8*)(Ks + KSWZ(r32, cb));
        const bf16x8 b1 = *(const LAS bf16x8*)(Ks + KSWZ(32 + r32, cb));
        p0 = __builtin_amdgcn_mfma_f32_32x32x16_bf16(b0, qr[d0], p0, 0, 0, 0);
        p1 = __builtin_amdgcn_mfma_f32_32x32x16_bf16(b1, qr[d0], p1, 0, 0, 0); }
}
DI int v_st(int k, int c) { const int kk = (k & ~0xC) | ((k & 4) << 1) | ((k & 8) >> 1); return ((kk >> 3) * 2 + (c >> 5)) * 512 + ((kk & 7) * 32 + (c & 31)) * 2; }
DI int v_rd_base(int lane) { return ((lane & 3) << 3) | (((lane >> 2) & 3) << 6) | (((lane >> 4) & 1) << 5) | (((lane >> 5) & 1) << 8); }
constexpr int v_rd_off(int d0, int ks, int half) { return d0 * 512 + ks * 2048 + half * 1024; }
template <int OFF> DI s16x4 tr_read(int vb) { s16x4 r; asm volatile("ds_read_b64_tr_b16 %0, %1 offset:%2" : "=&v"(r) : "v"(vb), "i"(OFF) : "memory"); return r; }
template <int D0> DI void pv_one(f32x16& od, int vb, bf16x8 pa0, bf16x8 pa1, bf16x8 pa2, bf16x8 pa3) {
    const s16x4 l0 = tr_read<v_rd_off(D0, 0, 0)>(vb), h0 = tr_read<v_rd_off(D0, 0, 1)>(vb), l1 = tr_read<v_rd_off(D0, 1, 0)>(vb), h1 = tr_read<v_rd_off(D0, 1, 1)>(vb);
    const s16x4 l2 = tr_read<v_rd_off(D0, 2, 0)>(vb), h2 = tr_read<v_rd_off(D0, 2, 1)>(vb), l3 = tr_read<v_rd_off(D0, 3, 0)>(vb), h3 = tr_read<v_rd_off(D0, 3, 1)>(vb);
    asm volatile("s_waitcnt lgkmcnt(0)" ::: "memory"); SBAR();
#define PKV(L, H) (bf16x8){L[0], L[1], L[2], L[3], H[0], H[1], H[2], H[3]}
    od = __builtin_amdgcn_mfma_f32_32x32x16_bf16(pa0, PKV(l0, h0), od, 0, 0, 0);
    od = __builtin_amdgcn_mfma_f32_32x32x16_bf16(pa1, PKV(l1, h1), od, 0, 0, 0);
    od = __builtin_amdgcn_mfma_f32_32x32x16_bf16(pa2, PKV(l2, h2), od, 0, 0, 0);
    od = __builtin_amdgcn_mfma_f32_32x32x16_bf16(pa3, PKV(l3, h3), od, 0, 0, 0);
#undef PKV
}
DI void pv_d0(f32x16* o, int vb, bf16x8 pa0, bf16x8 pa1, bf16x8 pa2, bf16x8 pa3) {
    pv_one<0>(o[0], vb, pa0, pa1, pa2, pa3); pv_one<1>(o[1], vb, pa0, pa1, pa2, pa3);
}
DI void attn_unit(const Frame& F, const bf16_t* __restrict__ Qb, const bf16_t* __restrict__ Kh, const bf16_t* __restrict__ Vh, bf16_t* __restrict__ Ob, int seq) {
    const int tid = F.tid, wid = F.wid, lane = F.lane, r32 = lane & 31, hi = lane >> 5;
    LAS unsigned char* V_lds = F.lds; LAS unsigned char* K_lds = F.lds + 2 * AT_SHM_V;
    LAS float* ws = (LAS float*)(F.lds + 2 * AT_SHM_V + 2 * AT_SHM_K) + wid * 64; LAS float* li_l = ws; LAS float* al_l = ws + 32;
    float m_reg = -1e30f, l_reg = 0;
    f32x16 o[2];
#pragma unroll
    for (int r = 0; r < 16; ++r) { o[0][r] = 0.f; o[1][r] = 0.f; }
    bf16x8 qr[6];
    const bf16_t* Qw = Qb + (size_t)(wid * 32 + r32) * 96 + hi * 8;
#pragma unroll
    for (int d0 = 0; d0 < 6; ++d0) qr[d0] = *(const bf16x8*)(Qw + d0 * 16);
    const int sr = tid >> 4, sc = (tid & 15) * 8;
    const int vk = tid >> 3, vc = (tid & 7) * 8;
    const int vst = v_st(vk, vc);
    const int vb0 = (int)(uintptr_t)V_lds + v_rd_base(lane);
    struct { bf16x8 vs0, ks0, ks1; } sr_[2];
#define SLOAD(i, k0) do { sr_[i].vs0 = *(const bf16x8*)(Vh + (size_t)((k0) + vk) * 64 + vc); \
    sr_[i].ks0 = *(const bf16x8*)(Kh + (size_t)((k0) + sr) * 128 + sc); sr_[i].ks1 = *(const bf16x8*)(Kh + (size_t)((k0) + 32 + sr) * 128 + sc); } while (0)
#define SWRITE(b, i) do { *(LAS bf16x8*)(V_lds + (b) * AT_SHM_V + vst) = sr_[i].vs0; const int kc = sc * 2; \
    *(LAS bf16x8*)(K_lds + (b) * AT_SHM_K + KSWZ(sr, kc)) = sr_[i].ks0; *(LAS bf16x8*)(K_lds + (b) * AT_SHM_K + KSWZ(32 + sr, kc)) = sr_[i].ks1; } while (0)
#define SWAIT() asm volatile("s_waitcnt vmcnt(3)" ::: "memory")
#define RESC(a) do { if (__any((a) < 1.f)) { if (hi == 0) al_l[r32] = (a); asm volatile("s_waitcnt lgkmcnt(0)" ::: "memory"); \
    _Pragma("unroll") for (int d = 0; d < 2; ++d) _Pragma("unroll") for (int r = 0; r < 16; ++r) o[d][r] *= al_l[crow(r, hi)]; } } while (0)
    f32x16 pA0, pA1, pB0, pB1; float mnA, mnB, alA, alB; bf16x8 pa0, pa1, pa2, pa3; const int NT = seq / 64;
    __syncthreads();
    SLOAD(0, 0); asm volatile("s_waitcnt vmcnt(0)" ::: "memory"); SWRITE(0, 0); __syncthreads();
    qkt(pA0, pA1, K_lds, qr, r32, hi); partialSM(pA0, pA1, m_reg, mnA, alA);
    SLOAD(1, 64); if (2 < NT) SLOAD(0, 128);
    SWAIT(); SWRITE(1, 1); __syncthreads();
    for (int j = 1; j + 1 < NT; j += 2) {
        SBAR(); qkt(pB0, pB1, K_lds + AT_SHM_K, qr, r32, hi);
        finishSM(pA0, pA1, alA, l_reg, pa0, pa1, pa2, pa3); SBAR();
        SLOAD(1, (j + 2) * 64); SBAR();
        pv_d0(o, vb0, pa0, pa1, pa2, pa3); partialSM(pB0, pB1, m_reg, mnB, alB);
        __syncthreads(); SWAIT(); SWRITE(0, 0);
        RESC(alB); __syncthreads();
        SBAR(); qkt(pA0, pA1, K_lds, qr, r32, hi);
        finishSM(pB0, pB1, alB, l_reg, pa0, pa1, pa2, pa3); SBAR();
        if (j + 3 < NT) SLOAD(0, (j + 3) * 64); SBAR();
        pv_d0(o, vb0 + AT_SHM_V, pa0, pa1, pa2, pa3); partialSM(pA0, pA1, m_reg, mnA, alA);
        __syncthreads(); SWAIT(); SWRITE(1, 1);
        RESC(alA); __syncthreads();
    }
    SBAR(); qkt(pB0, pB1, K_lds + AT_SHM_K, qr, r32, hi);
    finishSM(pA0, pA1, alA, l_reg, pa0, pa1, pa2, pa3); SBAR();
    pv_d0(o, vb0, pa0, pa1, pa2, pa3); partialSM(pB0, pB1, m_reg, mnB, alB);
    __syncthreads(); RESC(alB);
    finishSM(pB0, pB1, alB, l_reg, pa0, pa1, pa2, pa3); SBAR();
    pv_d0(o, vb0 + AT_SHM_V, pa0, pa1, pa2, pa3);
    if (hi == 0) li_l[r32] = l_reg; asm volatile("s_waitcnt lgkmcnt(0)" ::: "memory");
    float rli[16];
#pragma unroll
    for (int r = 0; r < 16; ++r) rli[r] = __builtin_amdgcn_rcpf(li_l[crow(r, hi)]);
    bf16_t* Ow = Ob + (size_t)(wid * 32) * 1024;
#pragma unroll
    for (int r = 0; r < 16; ++r) { const int orow = crow(r, hi);
#pragma unroll
        for (int d0 = 0; d0 < 2; ++d0) Ow[(size_t)orow * 1024 + d0 * 32 + r32] = (bf16_t)f2bf(o[d0][r] * rli[r]); }
#undef SLOAD
#undef SWRITE
#undef SWAIT
#undef RESC
}

DI void hgrn_fix_unit(const Frame& F, int l, int u) {
    const int tid = F.tid, lane = F.lane, wid = F.wid;
    const int b = u / (4 * NSEG), hh = (u / NSEG) & 3, seg = u % NSEG;
    LAS float* SI = (LAS float*)F.lds;
    __syncthreads();
    for (int dir = 0; dir < 2; ++dir) {
        const int chain = b * 8 + hh * 2 + dir;
        const int sseg = (seg == 0) ? 0 : (dir == 0 ? seg : NSEG - seg);
        const float* SL = WSP(const float, WS_SLOC) + (size_t)chain * NSEG * 8192;
        const float* DT = WSP(const float, WS_DTOT) + (size_t)chain * NSEG * 128;
#pragma unroll 1
        for (int i = 0; i < 16; ++i) {
            const int idx = tid + i * 512, d = idx >> 6;
            float a = 0.f;
            for (int j = 0; j < sseg; ++j) a = fmaf(expf(DT[j * 128 + d]), a, SL[(size_t)j * 8192 + idx]);
            SI[dir * 8192 + idx] = a;
        }
    }
    __syncthreads();
    const int len = seg == 0 ? 256 : 512, t0 = seg == 0 ? 0 : (seg - 1) * 512;
    const size_t rowbase = seg == 0 ? (size_t)NLAT + b * CTX : (size_t)b * SEQ;
    const float* OL0 = WSP(const float, WS_OLOC); const float* OL1 = OL0 + (size_t)NTOK * 256;
    const bf16_t* QC0 = WSP(const bf16_t, WS_QCUM); const bf16_t* QC1 = QC0 + (size_t)NTOK * 512;
    const float ng = inp(F, I_HGNG)[l * 256 + hh * 64 + lane];
    for (int tk = wid; tk < len; tk += 8) {
        const size_t row = rowbase + t0 + tk;
        float o = OL0[row * 256 + hh * 64 + lane] + OL1[row * 256 + hh * 64 + lane];
        if (seg != 0) {
            const float qa0 = bf2f(QC0[row * 512 + hh * 128 + lane]), qa1 = bf2f(QC0[row * 512 + hh * 128 + 64 + lane]);
            const float qb0 = bf2f(QC1[row * 512 + hh * 128 + lane]), qb1 = bf2f(QC1[row * 512 + hh * 128 + 64 + lane]);
#pragma unroll
            for (int d = 0; d < 64; ++d) {
                o = fmaf(__shfl(qa0, d), SI[d * 64 + lane], o);
                o = fmaf(__shfl(qa1, d), SI[(64 + d) * 64 + lane], o);
                o = fmaf(__shfl(qb0, d), SI[8192 + d * 64 + lane], o);
                o = fmaf(__shfl(qb1, d), SI[8192 + (64 + d) * 64 + lane], o);
            }
        }
        const float ss = wave_sum(o * o);
        const float gate = bf2f(WSP(const bf16_t, WS_GATE)[row * 256 + hh * 64 + lane]);
        const float r = o * rsqrtf(ss * (1.f / 64.f) + EPS) * ng * gate;
        WSP(bf16_t, WS_MIX)[row * 1024 + 256 + hh * 64 + lane] = (bf16_t)f2bf(r);
    }
}

DI void phase_attn(const Frame& Fin, int l) {
    PHASE_FRAME(Fin);
    for (int u = F.bid; u < 528; u += F.G) {
        if (u < 512) {
            const int bh = u >> 5, qb = u & 31, b = bh >> 3, hd = bh & 7;
            const size_t kv0 = (size_t)bh * NKEY;
            attn_unit(F, WSP(const bf16_t, WS_QB) + (kv0 + qb * 256) * 96, WSP(const bf16_t, WS_KB) + kv0 * 128, WSP(const bf16_t, WS_VB) + kv0 * 64,
                      WSP(bf16_t, WS_MIX) + ((size_t)b * SEQ + qb * 256) * 1024 + 512 + hd * 64, NKEY);
        } else {
            const int bh = u - 512, b = bh >> 3, hd = bh & 7;
            const size_t kv0 = (size_t)bh * NKEY + SEQ;
            attn_unit(F, WSP(const bf16_t, WS_QB) + kv0 * 96, WSP(const bf16_t, WS_KB) + kv0 * 128, WSP(const bf16_t, WS_VB) + kv0 * 64,
                      WSP(bf16_t, WS_MIX) + ((size_t)NLAT + b * CTX) * 1024 + 512 + hd * 64, CTX);
        }
    }
    __syncthreads();
    for (int u = F.bid; u < 2 * 4 * NSEG; u += F.G) hgrn_fix_unit(F, l, u);
}

DI void phase_wout(const Frame& Fin) {
    PHASE_FRAME(Fin);
    const int wid = F.wid, lane = F.lane, wr = wid >> 1, wc = wid & 1, fr = lane & 15, fq = lane >> 4;
    for (int u = F.bid; u < 66 * 8; u += F.G) {
        const int rt = u >> 3, ct = u & 7;
        GemmTile g; g.A = WSP(const bf16_t, WS_MIX); g.lda = 1024; g.rowidx = nullptr; g.nvalid = 0; g.arow0 = (long)rt * 256;
        g.Bt = WSP(const bf16_t, WS_WOUT); g.ldb = 1024; g.brow0 = (long)ct * 128; g.K = 1024;
        f32x4 acc[4][4]; float ssq[4];
        gemm_tile<false>(F, g, acc, ssq);
#pragma unroll
        for (int m = 0; m < 4; ++m) {
            const size_t row = (size_t)rt * 256 + wr * 64 + m * 16 + fr;
#pragma unroll
            for (int n = 0; n < 4; ++n) *(f32x4*)(WSP(float, WS_M) + row * 1024 + ct * 128 + wc * 64 + n * 16 + fq * 4) = acc[m][n];
        }
    }
}

DI void phase_ln1_router(const Frame& Fin, int l) {
    PHASE_FRAME(Fin);
    const int tid = F.tid, lane = F.lane;
    LAS float* RW = (LAS float*)F.lds;
    __syncthreads();
    for (int i = tid; i < 1024 * 36; i += 512) {
        const int k = i / 36, c = i % 36;
        RW[c * 1024 + k] = c < 4 ? inp(F, I_RGW)[((size_t)l * 1024 + k) * 4 + c] : inp(F, I_REW)[((size_t)l * 1024 + k) * 32 + (c - 4)];
    }
    __syncthreads();
    unsigned* cnt = WSP(unsigned, WS_CTL) + CW_CNT + l * 32;
    for (int row = F.bid * 8 + F.wid; row < NTOK; row += F.G * 8) {
        const float* md = WSP(const float, WS_MOD) + (size_t)(l * 3 + row_seq(row)) * 6144;
        float v[16], t[16];
        row_load(x_in_row(F, l, row), lane, v);
        row_load(WSP(const float, WS_M) + (size_t)row * DM, lane, t);
        { float g1[16]; row_load(md + 2048, lane, g1);
#pragma unroll
          for (int i = 0; i < 16; ++i) v[i] = fmaf(ALPHA, v[i], g1[i] * t[i]); }
        row_ln(v);
        { float a[16], bb[16]; row_load(inp(F, I_LN1G) + l * 1024, lane, a); row_load(inp(F, I_LN1B) + l * 1024, lane, bb);
#pragma unroll
          for (int i = 0; i < 16; ++i) v[i] = fmaf(v[i], a[i], bb[i]); }
        row_store(WSP(float, WS_X1) + (size_t)row * DM, lane, v);
        row_ln(v);
        { float sh[16], sc[16]; row_load(md + 3072, lane, sh); row_load(md + 4096, lane, sc);
#pragma unroll
          for (int i = 0; i < 16; ++i) v[i] = fmaf(v[i], 1.f + sc[i], sh[i]); }
        row_store_bf16(WSP(bf16_t, WS_H) + (size_t)row * DM, lane, v);
        float lg[36];
#pragma unroll
        for (int c = 0; c < 36; ++c) {
            float s = 0.f;
#pragma unroll
            for (int i = 0; i < 4; ++i) { const f32x4 w = *(const LAS f32x4*)(RW + c * 1024 + lane * 4 + i * 256);
                s = fmaf(v[4 * i], w[0], s); s = fmaf(v[4 * i + 1], w[1], s); s = fmaf(v[4 * i + 2], w[2], s); s = fmaf(v[4 * i + 3], w[3], s); }
            lg[c] = wave_sum(s);
        }
        if (lane == 0) {
            float g[4]; int gs = 0; float gm;
#pragma unroll
            for (int c = 0; c < 4; ++c) g[c] = lg[c] + inp(F, I_RGB)[l * 4 + c];
            gm = g[0];
#pragma unroll
            for (int c = 1; c < 4; ++c) if (g[c] > gm) { gm = g[c]; gs = c; }
            float se = 0.f;
#pragma unroll
            for (int c = 0; c < 4; ++c) se += expf(g[c] - gm);
            const float wg = 1.f / se;
            float e[8];
#pragma unroll
            for (int c = 0; c < 8; ++c) {
                float val = 0.f;
#pragma unroll
                for (int q = 0; q < 4; ++q) val = (gs == q) ? lg[4 + q * 8 + c] : val;
                e[c] = val + inp(F, I_REB)[l * 32 + gs * 8 + c];
            }
            int i0 = 0; float v0 = e[0];
#pragma unroll
            for (int c = 1; c < 8; ++c) if (e[c] > v0) { v0 = e[c]; i0 = c; }
            int i1 = -1; float v1 = -3.0e38f;
#pragma unroll
            for (int c = 0; c < 8; ++c) if (c != i0 && e[c] > v1) { v1 = e[c]; i1 = c; }
            const float p1 = expf(v1 - v0), den = 1.f / (1.f + p1);
            const float w0 = den * wg, w1 = p1 * den * wg;
            const int e0 = gs * 8 + i0, e1 = gs * 8 + i1;
            const unsigned pos0 = atomicAdd(&cnt[e0], 1u), pos1 = atomicAdd(&cnt[e1], 1u);
            WSP(int, WS_LIST)[(size_t)e0 * NTOK + pos0] = row; WSP(float, WS_LISTW)[(size_t)e0 * NTOK + pos0] = w0;
            WSP(int, WS_LIST)[(size_t)e1 * NTOK + pos1] = row; WSP(float, WS_LISTW)[(size_t)e1 * NTOK + pos1] = w1;
            int* ts = WSP(int, WS_TOKSLOT) + (size_t)row * 4; ts[0] = e0; ts[1] = (int)pos0; ts[2] = e1; ts[3] = (int)pos1;
        }
    }
}

DI void moe_bases(const Frame& F, int l, LAS int* base  , LAS int* cnts  ) {
    __syncthreads();
    if (F.tid == 0) {
        const unsigned* cnt = WSP(const unsigned, WS_CTL) + CW_CNT + l * 32;
        int a = 0;
        for (int e = 0; e < 32; ++e) { const int c = (int)cnt[e]; cnts[e] = c; base[e] = a; a += (c + 255) / 256 * 256; }
        base[32] = a;
    }
    __syncthreads();
}

DI void phase_moe_up(const Frame& Fin, int l) {
    PHASE_FRAME(Fin);
    const int wid = F.wid, lane = F.lane, wr = wid >> 1, wc = wid & 1, fr = lane & 15, fq = lane >> 4;
    LAS int* base = (LAS int*)(F.lds + LDS_MAIN + 64); LAS int* cnts = base + 40;
    moe_bases(F, l, base, cnts);
    const int ntile = base[32] / 256;
    for (int u = F.bid; u < ntile * 8; u += F.G) {
        const int rt = u >> 3, ct = u & 7, slot0 = rt * 256;
        int e = 0;
        for (int q = 1; q < 32; ++q) if (slot0 >= base[q]) e = q;
        const int pos0 = slot0 - base[e];
        GemmTile g; g.A = WSP(const bf16_t, WS_H); g.lda = 1024; g.rowidx = WSP(const int, WS_LIST) + (size_t)e * NTOK + pos0; g.nvalid = cnts[e] - pos0; g.arow0 = 0;
        g.Bt = WSP(const bf16_t, WS_W13) + (size_t)e * 1024 * 1024; g.ldb = 1024; g.brow0 = (long)ct * 128; g.K = 1024;
        f32x4 acc[4][4]; float ssq[4];
        gemm_tile<false>(F, g, acc, ssq);
        bf16_t* ACT = WSP(bf16_t, WS_ACT);
#pragma unroll
        for (int m = 0; m < 4; ++m) {
            const size_t slot = (size_t)slot0 + wr * 64 + m * 16 + fr;
#pragma unroll
            for (int pp = 0; pp < 2; ++pp) {
                const f32x4 a = acc[m][2 * pp], bq = acc[m][2 * pp + 1];
                const int hc = 16 * ((ct * 128 + wc * 64) / 32 + pp) + fq * 4;
                *(u32x2*)(ACT + slot * 512 + hc) = (u32x2){cvtpk(silu_f(a[0]) * bq[0], silu_f(a[1]) * bq[1]), cvtpk(silu_f(a[2]) * bq[2], silu_f(a[3]) * bq[3])};
            }
        }
    }
}
DI void phase_moe_down(const Frame& Fin, int l) {
    PHASE_FRAME(Fin);
    const int wid = F.wid, lane = F.lane, wr = wid >> 1, wc = wid & 1, fr = lane & 15, fq = lane >> 4;
    LAS int* base = (LAS int*)(F.lds + LDS_MAIN + 64); LAS int* cnts = base + 40;
    moe_bases(F, l, base, cnts);
    const int ntile = base[32] / 256;
    for (int u = F.bid; u < ntile * 8; u += F.G) {
        const int rt = u >> 3, ct = u & 7, slot0 = rt * 256;
        int e = 0;
        for (int q = 1; q < 32; ++q) if (slot0 >= base[q]) e = q;
        const int pos0 = slot0 - base[e];
        GemmTile g; g.A = WSP(const bf16_t, WS_ACT); g.lda = 512; g.rowidx = nullptr; g.nvalid = 0; g.arow0 = slot0;
        g.Bt = WSP(const bf16_t, WS_W2) + (size_t)e * 1024 * 512; g.ldb = 512; g.brow0 = (long)ct * 128; g.K = 512;
        f32x4 acc[4][4]; float ssq[4];
        gemm_tile<false>(F, g, acc, ssq);
        bf16_t* Y = WSP(bf16_t, WS_Y);
#pragma unroll
        for (int m = 0; m < 4; ++m) {
            const int r = wr * 64 + m * 16 + fr, pos = pos0 + r;
            const float w = pos < cnts[e] ? WSP(const float, WS_LISTW)[(size_t)e * NTOK + pos] : 0.f;
#pragma unroll
            for (int n = 0; n < 4; ++n) {
                const f32x4 v = acc[m][n] * w;
                *(u32x2*)(Y + (size_t)(slot0 + r) * 1024 + ct * 128 + wc * 64 + n * 16 + fq * 4) = (u32x2){cvtpk(v[0], v[1]), cvtpk(v[2], v[3])};
            }
        }
    }
}

DI void row_load_bf16(const bf16_t* p, int lane, float (&v)[16]) {
#pragma unroll
    for (int i = 0; i < 4; ++i) { const u32x2 t = *(const u32x2*)(p + lane * 4 + i * 256); v[4 * i] = bf2f(t[0] & 0xffffu); v[4 * i + 1] = bf2f(t[0] >> 16); v[4 * i + 2] = bf2f(t[1] & 0xffffu); v[4 * i + 3] = bf2f(t[1] >> 16); }
}
DI void phase_ln2(const Frame& Fin, int l) {
    PHASE_FRAME(Fin);
    const int lane = F.lane;
    LAS int* base = (LAS int*)(F.lds + LDS_MAIN + 64); LAS int* cnts = base + 40;
    moe_bases(F, l, base, cnts);
    for (int row = F.bid * 8 + F.wid; row < NTOK; row += F.G * 8) {
        if (l == 3 && row >= NLAT) continue;
        const float* md = WSP(const float, WS_MOD) + (size_t)(l * 3 + row_seq(row)) * 6144;
        const int* ts = WSP(const int, WS_TOKSLOT) + (size_t)row * 4;
        const size_t s0 = (size_t)base[ts[0]] + ts[1], s1 = (size_t)base[ts[2]] + ts[3];
        float v[16], y0[16], y1[16];
        row_load(WSP(const float, WS_X1) + (size_t)row * DM, lane, v);
        row_load_bf16(WSP(const bf16_t, WS_Y) + s0 * 1024, lane, y0);
        row_load_bf16(WSP(const bf16_t, WS_Y) + s1 * 1024, lane, y1);
        { float g2[16]; row_load(md + 5120, lane, g2);
#pragma unroll
          for (int i = 0; i < 16; ++i) v[i] = fmaf(ALPHA, v[i], g2[i] * (y0[i] + y1[i])); }
        row_ln(v);
        { float a[16], bb[16]; row_load(inp(F, I_LN2G) + l * 1024, lane, a); row_load(inp(F, I_LN2B) + l * 1024, lane, bb);
#pragma unroll
          for (int i = 0; i < 16; ++i) v[i] = fmaf(v[i], a[i], bb[i]); }
        if (l == 3) { row_store((float*)(F.out + (size_t)row * DM), lane, v); continue; }
        row_store(WSP(float, WS_X) + (size_t)row * DM, lane, v);
        row_ln(v);
        const float* md2 = WSP(const float, WS_MOD) + (size_t)((l + 1) * 3 + row_seq(row)) * 6144;
        { float sh[16], sc[16]; row_load(md2, lane, sh); row_load(md2 + 1024, lane, sc);
#pragma unroll
          for (int i = 0; i < 16; ++i) v[i] = fmaf(v[i], 1.f + sc[i], sh[i]); }
        row_store_bf16(WSP(bf16_t, WS_H) + (size_t)row * DM, lane, v);
    }
    if (l < 3) { __syncthreads(); phase_convert(F, l + 1); }
}

constexpr int N_STEPS = 2 + 4 * 8;
__global__ void __launch_bounds__(512, 2) mega(Params P) {
    extern __shared__ __attribute__((aligned(16))) unsigned char lds_raw[];
    Frame F;
    F.in = (kin_t)__builtin_amdgcn_kernarg_segment_ptr();
    F.out = (GAS float*)P.out; F.ws = (GAS unsigned char*)P.ws; F.lds = (LAS unsigned char*)lds_raw;
    F.tid = threadIdx.x; F.lane = F.tid & 63; F.wid = __builtin_amdgcn_readfirstlane(F.tid >> 6); F.G = gridDim.x; F.bid = blockIdx.x;
    const int s_lo = P.s_lo, s_hi = P.s_hi;
    if (F.tid < 64) ((LAS unsigned*)(F.lds + LDS_MAIN))[F.tid] = 0u;
    __syncthreads();
    XcdBarrier bar; bar.bar = WSP(unsigned, WS_CTL) + CW_BAR; bar.x = 0; bar.st = (volatile LAS unsigned*)(F.lds + LDS_MAIN);
    if (s_hi - s_lo > 1) bar = xcd_barrier_post(WSP(unsigned, WS_CTL) + CW_BAR, (volatile LAS unsigned*)(F.lds + LDS_MAIN));
#if defined(EXCL_PH)
#define PH_ON(k) ((k) != EXCL_PH)
#elif !defined(ONLY_PH)
#define PH_ON(k) true
#else
#define PH_ON(k) ((k) == ONLY_PH)
#endif
#define STEP(s) (s_lo <= (s) && (s) < s_hi)
#define SEAM(s) do { if (STEP(s) && STEP((s) + 1)) xcd_barrier(bar); } while (0)
    if (STEP(0) && PH_ON(0)) phase_setup(F);
    SEAM(0);
    if (STEP(1) && PH_ON(1)) phase_mod0(F);
    SEAM(1);
#pragma unroll 1
    for (int l = 0; l < 4; ++l) {
        const int sb = 2 + l * 8;
        if (STEP(sb + 0) && PH_ON(2)) phase_proj(F, l);
        SEAM(sb + 0);
        if (STEP(sb + 1) && PH_ON(3)) phase_local(F, l);
        SEAM(sb + 1);
        if (STEP(sb + 2) && PH_ON(4)) phase_attn(F, l);
        SEAM(sb + 2);
        if (STEP(sb + 3) && PH_ON(5)) phase_wout(F);
        SEAM(sb + 3);
        if (STEP(sb + 4) && PH_ON(6)) phase_ln1_router(F, l);
        SEAM(sb + 4);
        if (STEP(sb + 5) && PH_ON(7)) phase_moe_up(F, l);
        SEAM(sb + 5);
        if (STEP(sb + 6) && PH_ON(8)) phase_moe_down(F, l);
        SEAM(sb + 6);
        if (STEP(sb + 7) && PH_ON(9)) phase_ln2(F, l);
        SEAM(sb + 7);
    }
}

extern "C" void kernel_launch(void* const* d_in, const int* in_sizes, int n_in, void* d_out, int out_size, void* d_ws, size_t ws_size, hipStream_t stream) {
    static int grid = 0;
    if (grid == 0) {
        if (n_in != 27 || out_size != NLAT * DM || ws_size < WS_END) {
            fprintf(stderr, "kernel_launch: shape mismatch: n_in %d out %d ws %zu (need %zu)\n", n_in, out_size, ws_size, (size_t)WS_END); grid = -1; return; }
        int dev = 0, cus = 0, per_cu = 0;
        if (hipGetDevice(&dev) != hipSuccess || hipDeviceGetAttribute(&cus, hipDeviceAttributeMultiprocessorCount, dev) != hipSuccess) { grid = -1; return; }
        if (hipFuncSetAttribute((const void*)mega, hipFuncAttributeMaxDynamicSharedMemorySize, LDS_BYTES) != hipSuccess) { fprintf(stderr, "kernel_launch: hipFuncSetAttribute failed\n"); grid = -1; return; }
        if (hipOccupancyMaxActiveBlocksPerMultiprocessor(&per_cu, (const void*)mega, 512, LDS_BYTES) != hipSuccess || per_cu < 1) fprintf(stderr, "kernel_launch: occupancy query says %d\n", per_cu);
        (void)hipGetLastError();
        grid = cus;
    }
    if (grid < 0) return;
    if (hipMemsetAsync((char*)d_ws + WS_CTL, 0, CTL_BYTES, stream) != hipSuccess) return;
    Params p{};
    for (int i = 0; i < 27; ++i) p.in[i] = (const float*)d_in[i];
    p.out = (float*)d_out; p.ws = (unsigned char*)d_ws;
#if MK_MULTI
    for (int s = 0; s < N_STEPS; ++s) { p.s_lo = s; p.s_hi = s + 1; hipLaunchKernelGGL(mega, dim3(grid), dim3(512), LDS_BYTES, stream, p); }
#else
    p.s_lo = 0; p.s_hi = N_STEPS;
    hipLaunchKernelGGL(mega, dim3(grid), dim3(512), LDS_BYTES, stream, p);
#endif
    const hipError_t le = hipPeekAtLastError();
    if (le != hipSuccess) fprintf(stderr, "kernel_launch: launch failed: %s\n", hipGetErrorName(le));
}
```

```cpp
#include <hip/hip_runtime.h>
#include <cstdio>
#include <cstdint>

#ifndef MK_MULTI
#define MK_MULTI 0
#endif

typedef unsigned short bf16_t;
typedef short bf16x8 __attribute__((ext_vector_type(8)));
typedef short s16x4 __attribute__((ext_vector_type(4)));
typedef float f32x4 __attribute__((ext_vector_type(4)));
typedef float f32x16 __attribute__((ext_vector_type(16)));
typedef unsigned u32x4 __attribute__((ext_vector_type(4)));
typedef unsigned u32x2 __attribute__((ext_vector_type(2)));
#define LAS __attribute__((address_space(3)))
#define DI __device__ __forceinline__

DI unsigned f2bf(float f) { unsigned u = __float_as_uint(f); return (u + 0x7fffu + ((u >> 16) & 1u)) >> 16; }
DI float bf2f(unsigned h) { return __uint_as_float(h << 16); }
typedef float f32x2_t __attribute__((ext_vector_type(2)));
typedef __bf16 bf16x2_t __attribute__((ext_vector_type(2)));
DI unsigned cvtpk_c(float lo, float hi) { const f32x2_t v = {lo, hi}; const bf16x2_t b = __builtin_convertvector(v, bf16x2_t); return __builtin_bit_cast(unsigned, b); }
DI unsigned cvtpk(float lo, float hi) { unsigned r; asm volatile("v_cvt_pk_bf16_f32 %0, %1, %2" : "=v"(r) : "v"(lo), "v"(hi)); return r; }
DI float silu_f(float x) { return x / (1.f + __expf(-x)); }
DI float wave_sum(float v) {
#pragma unroll
    for (int o = 32; o >= 1; o >>= 1) v += __shfl_xor(v, o);
    return v;
}

constexpr int NLAT = 16384, NCTXT = 512, NTOK = 16896, DM = 1024, SEQ = 8192, CTX = 256, NKEY = 8448;
constexpr int INDIM = 2720, INPAD = 2816;
constexpr int NEXP = 32, DEXP = 512;
constexpr int NSLOT = 41984;
constexpr float EPS = 1e-6f;
constexpr float ALPHA = 1.6817928305074290f;
constexpr int NSEG = 17;

constexpr size_t al256(size_t x) { return (x + 255) / 256 * 256; }
constexpr size_t WS_CTL = 0, CTL_BYTES = 1u << 20;
constexpr size_t WS_MOD = WS_CTL + CTL_BYTES;
constexpr size_t WS_LB = WS_MOD + al256(4 * 3 * 6144 * 4);
constexpr size_t WS_ROPE = WS_LB + al256(4 * 2 * 512 * 4);
constexpr size_t WS_X = WS_ROPE + al256(2 * 8192 * 16 * 4);
constexpr size_t WS_X1 = WS_X + al256((size_t)NTOK * DM * 4);
constexpr size_t WS_H = WS_X1 + al256((size_t)NTOK * DM * 4);
constexpr size_t WS_PA = WS_H + al256((size_t)NTOK * DM * 2);
constexpr size_t WS_QH = WS_PA + al256((size_t)NTOK * 256 * 2);
constexpr size_t WS_GF = WS_QH + al256((size_t)NTOK * 512 * 2);
constexpr size_t WS_GB = WS_GF + al256((size_t)NTOK * 512 * 4);
constexpr size_t WS_VH = WS_GB + al256((size_t)NTOK * 512 * 4);
constexpr size_t WS_GATE = WS_VH + al256((size_t)NTOK * 256 * 2);
constexpr size_t WS_CQKV = WS_GATE + al256((size_t)NTOK * 256 * 2);
constexpr size_t WS_QB = WS_CQKV + al256((size_t)NTOK * 416 * 2);
constexpr size_t WS_KB = WS_QB + al256((size_t)16 * NKEY * 96 * 2);
constexpr size_t WS_VB = WS_KB + al256((size_t)16 * NKEY * 128 * 2);
constexpr size_t WS_MIX = WS_VB + al256((size_t)16 * NKEY * 64 * 2);
constexpr size_t WS_M = WS_MIX + al256((size_t)NTOK * DM * 2);
constexpr size_t WS_OLOC = WS_M + al256((size_t)NTOK * DM * 4);
constexpr size_t WS_QCUM = WS_OLOC + al256((size_t)2 * NTOK * 256 * 4);
constexpr size_t WS_SLOC = WS_QCUM + al256((size_t)2 * NTOK * 512 * 2);
constexpr size_t WS_DTOT = WS_SLOC + al256((size_t)16 * NSEG * 8192 * 4);
constexpr size_t WS_LIST = WS_DTOT + al256((size_t)16 * NSEG * 128 * 4);
constexpr size_t WS_LISTW = WS_LIST + al256((size_t)NEXP * NTOK * 4);
constexpr size_t WS_TOKSLOT = WS_LISTW + al256((size_t)NEXP * NTOK * 4);
constexpr size_t WS_ACT = WS_TOKSLOT + al256((size_t)NTOK * 16);
constexpr size_t WS_Y = WS_ACT + al256((size_t)NSLOT * 512 * 2);
constexpr size_t WS_WIN = WS_Y + al256((size_t)NSLOT * 1024 * 2);
constexpr size_t WS_WOUT = WS_WIN + al256((size_t)INPAD * 1024 * 2);
constexpr size_t WS_WUQ = WS_WOUT + al256((size_t)1024 * 1024 * 2);
constexpr size_t WS_WUKV = WS_WUQ + al256((size_t)768 * 256 * 2);
constexpr size_t WS_W13 = WS_WUKV + al256((size_t)1024 * 128 * 2);
constexpr size_t WS_W2 = WS_W13 + al256((size_t)NEXP * 1024 * 1024 * 2);
constexpr size_t WS_KF = WS_W2 + al256((size_t)NEXP * 1024 * 512 * 2);
constexpr size_t WS_KBW = WS_KF + al256((size_t)NTOK * 512 * 2);
constexpr size_t WS_END = WS_KBW + al256((size_t)NTOK * 512 * 2);

constexpr int CW_BAR = 4096;
constexpr int CW_CNT = 16384;

constexpr int LDS_MAIN = 147456;
constexpr int LDS_BYTES = LDS_MAIN + 1024;

struct Params {
    const float* in[27];
    float* out;
    unsigned char* ws;
    int s_lo, s_hi;
};
enum { I_X = 0, I_C, I_CTX, I_CCTX, I_WMOD, I_BMOD, I_WIN, I_POOLW, I_POOLS, I_LBLOG, I_HGNG, I_QNG, I_WUQ, I_KVNG, I_WUKV, I_WOUT,
       I_LN1G, I_LN1B, I_LN2G, I_LN2B, I_RGW, I_RGB, I_REW, I_REB, I_EW1, I_EW3, I_EW2 };

#define XB_TMO      128
#define XB_XCNT(j)  (256  + 64 * (j))
#define XB_XSUB(j)  (1280 + 64 * (j))
#define XB_XGEN(j)  (2304 + 64 * (j))
#define XB_TOP      3328
#define XB_TOPGEN   3392
#define XCD_BAR_WORDS 3456
#define XB_SPIN_CAP (1u << 18)

__device__ __forceinline__ unsigned xb_ld(unsigned* p)              { return __hip_atomic_load(p, __ATOMIC_RELAXED, __HIP_MEMORY_SCOPE_AGENT); }
__device__ __forceinline__ unsigned xb_add(unsigned* p, unsigned v) { return __hip_atomic_fetch_add(p, v, __ATOMIC_RELAXED, __HIP_MEMORY_SCOPE_AGENT); }
__device__ __forceinline__ unsigned xb_xcc_id() { return (unsigned)__builtin_amdgcn_s_getreg((3 << 11) | 20) & 0xFu; }
#define XB_SPIN(cond, bar) do { unsigned _sp = 0; while (cond) { __builtin_amdgcn_s_sleep(1); \
    if ((++_sp & 255u) == 0u) { if (xb_ld(&(bar)[XB_TMO])) break; if (_sp > XB_SPIN_CAP) { atomicAdd(&(bar)[XB_TMO], 1u); break; } } } } while (0)

struct XcdBarrier { unsigned* bar; unsigned x; volatile LAS unsigned* st; };

__device__ __forceinline__ XcdBarrier xcd_barrier_post(unsigned* bar, volatile LAS unsigned* st) {
    XcdBarrier b; b.bar = bar; b.x = xb_xcc_id(); b.st = st;
    if (threadIdx.x == 0) (void)xb_add(&bar[XB_XCNT(b.x)], 1u);
    return b;
}
__device__ __forceinline__ void xcd_barrier_complete(unsigned* bar, unsigned x, unsigned& nloc, unsigned& nx) {
    const unsigned G = gridDim.x * gridDim.y * gridDim.z;
    unsigned sum, cnt, mine, sp = 0u;
    for (;;) {
        sum = 0u; cnt = 0u; mine = 0u;
#pragma unroll
        for (unsigned j = 0; j < 16; ++j) { const unsigned c = xb_ld(&bar[XB_XCNT(j)]); sum += c; cnt += (c > 0u) ? 1u : 0u; mine = (j == x) ? c : mine; }
        if (sum == G) break;
        __builtin_amdgcn_s_sleep(1);
        if ((++sp & 255u) == 0u) { if (xb_ld(&bar[XB_TMO])) break; if (sp > XB_SPIN_CAP) { atomicAdd(&bar[XB_TMO], 1u); break; } }
    }
    nloc = mine > 0u ? mine : 1u; nx = cnt > 0u ? cnt : 1u;
}
__device__ __forceinline__ void xcd_barrier(const XcdBarrier& b) {
    asm volatile("s_waitcnt vmcnt(0)" ::: "memory");
    __syncthreads();
    if (threadIdx.x == 0) {
        unsigned* bar = b.bar;
        __builtin_amdgcn_s_waitcnt(0);
        unsigned nloc = b.st[0], nx = b.st[1];
        if (nloc == 0u) { xcd_barrier_complete(bar, b.x, nloc, nx); b.st[0] = nloc; b.st[1] = nx; }
        const unsigned old = xb_add(&bar[XB_XSUB(b.x)], 1u);
        const unsigned gen = old / nloc;
        if (old + 1u == (gen + 1u) * nloc) {
            __builtin_amdgcn_fence(__ATOMIC_RELEASE, "agent");
            asm volatile("s_waitcnt vmcnt(0)" ::: "memory");
            const unsigned og = xb_add(&bar[XB_TOP], 1u);
            const unsigned tg = og / nx;
            if (og + 1u == (tg + 1u) * nx) xb_add(&bar[XB_TOPGEN], 1u);
            else XB_SPIN(xb_ld(&bar[XB_TOPGEN]) == tg, bar);
            __builtin_amdgcn_fence(__ATOMIC_ACQUIRE, "agent");
            xb_add(&bar[XB_XGEN(b.x)], 1u);
            asm volatile("s_waitcnt vmcnt(0)" ::: "memory");
        } else {
            XB_SPIN(xb_ld(&bar[XB_XGEN(b.x)]) == gen, bar);
            __builtin_amdgcn_fence(__ATOMIC_ACQUIRE, "agent");
            asm volatile("s_waitcnt vmcnt(0)" ::: "memory");
        }
    }
    __syncthreads();
}

#define GAS __attribute__((address_space(1)))
typedef GAS const float* fptr_t;
typedef __attribute__((address_space(4))) const fptr_t* kin_t;
struct Frame {
    kin_t in;
    GAS float* out;
    GAS unsigned char* ws;
    LAS unsigned char* lds;
    int tid, lane, wid, G, bid;
};
#define WSP(T, off) ((T*)(GAS T*)(F.ws + (off)))
DI const float* inp(const Frame& F, int k) { return (const float*)F.in[k]; }
#define PHASE_FRAME(Fin) Frame F = (Fin); { int _t = F.tid; asm volatile("" : "+v"(_t)); F.tid = _t; F.lane = _t & 63; F.wid = __builtin_amdgcn_readfirstlane(_t >> 6); \
    asm volatile("" : "+s"(F.ws), "+s"(F.in), "+s"(F.out)); }

DI int row_seq(int row) { return row < NLAT ? (row >> 13) : 2; }
DI const float* x_in_row(const Frame& F, int l, int row) {
    if (l == 0) return row < NLAT ? inp(F, I_X) + (size_t)row * DM : inp(F, I_CTX) + (size_t)(row - NLAT) * DM;
    return WSP(const float, WS_X) + (size_t)row * DM;
}

DI int lds_byte(int r, int c) { const int st = (r >> 4) * 2 + (c >> 5), rr = r & 15, cc = c & 31, ob = rr * 64 + cc * 2; return st * 1024 + (ob ^ (((ob >> 9) & 1) << 5)); }
DI void stage_rc(int b, int& R, int& C) { const int st = b / 1024, sb = b % 1024, swz = sb ^ (((sb >> 9) & 1) << 5); R = (st >> 1) * 16 + swz / 64; C = (st & 1) * 32 + (swz % 64) / 2; }

struct GemmTile {
    const bf16_t* A; int lda; const int* rowidx; int nvalid; long arow0;
    const bf16_t* Bt; int ldb; long brow0;
    int K;
};
constexpr int GT_STAGE = 49152;

template <bool SSQ>
DI void gemm_tile(const Frame& F, const GemmTile& g, f32x4 (&acc)[4][4], float (&ssq)[4]) {
    const int tid = F.tid, wid = F.wid, lane = F.lane, wr = wid >> 1, wc = wid & 1, fr = lane & 15, fq = lane >> 4;
    LAS unsigned char* lds = F.lds;
    long aoff[2][2], boff[2];
#pragma unroll
    for (int i = 0; i < 2; ++i) {
        int R, C; stage_rc(tid * 16 + i * 8192, R, C);
#pragma unroll
        for (int h = 0; h < 2; ++h) {
            const int rr = h * 128 + R;
            long grow;
            if (g.rowidx) grow = (rr < g.nvalid) ? (long)g.rowidx[rr] : 0L; else grow = g.arow0 + rr;
            aoff[h][i] = grow * g.lda + C;
        }
        boff[i] = (g.brow0 + R) * g.ldb + C;
    }
#pragma unroll
    for (int m = 0; m < 4; ++m) {
        ssq[m] = 0.f;
#pragma unroll
        for (int n = 0; n < 4; ++n) acc[m][n] = (f32x4){0.f, 0.f, 0.f, 0.f};
    }
    const unsigned ldsw = (unsigned)wid * 1024u;
    const int a_rd = (wr >> 1) * 16384 + lds_byte((wr & 1) * 64 + fr, fq * 8);
    const int b_rd = 32768 + lds_byte(wc * 64 + fr, fq * 8);
#define GT_ISSUE(t, s) do { _Pragma("unroll") for (int _h = 0; _h < 2; ++_h) _Pragma("unroll") for (int _i = 0; _i < 2; ++_i) \
        __builtin_amdgcn_global_load_lds((const unsigned*)(g.A + aoff[_h][_i] + (t) * 64), (LAS unsigned*)(lds + (s) * GT_STAGE + _h * 16384 + ldsw + _i * 8192), 16, 0, 0); \
        _Pragma("unroll") for (int _i = 0; _i < 2; ++_i) \
        __builtin_amdgcn_global_load_lds((const unsigned*)(g.Bt + boff[_i] + (t) * 64), (LAS unsigned*)(lds + (s) * GT_STAGE + 32768 + ldsw + _i * 8192), 16, 0, 0); } while (0)
    const int nt = g.K >> 6;
    __builtin_amdgcn_s_barrier();
    GT_ISSUE(0, 0);
    for (int t = 0; t < nt; ++t) {
        const int cur = t & 1;
        if (t + 1 < nt) {
            __builtin_amdgcn_s_barrier();
            GT_ISSUE(t + 1, cur ^ 1);
            asm volatile("s_waitcnt vmcnt(6)" ::: "memory");
        } else {
            asm volatile("s_waitcnt vmcnt(0)" ::: "memory");
        }
        __builtin_amdgcn_s_barrier();
        LAS unsigned char* sb = lds + cur * GT_STAGE;
#pragma unroll
        for (int ks = 0; ks < 2; ++ks) {
            bf16x8 af[4], bfr[4];
#pragma unroll
            for (int m = 0; m < 4; ++m) af[m] = *(const LAS bf16x8*)(sb + a_rd + m * 2048 + ks * 1024);
#pragma unroll
            for (int n = 0; n < 4; ++n) bfr[n] = *(const LAS bf16x8*)(sb + b_rd + n * 2048 + ks * 1024);
            if (SSQ) {
#pragma unroll
                for (int m = 0; m < 4; ++m)
#pragma unroll
                    for (int j = 0; j < 8; ++j) { const float v = bf2f((unsigned)(unsigned short)af[m][j]); ssq[m] = fmaf(v, v, ssq[m]); }
            }
#pragma unroll
            for (int m = 0; m < 4; ++m)
#pragma unroll
                for (int n = 0; n < 4; ++n) acc[m][n] = __builtin_amdgcn_mfma_f32_16x16x32_bf16(bfr[n], af[m], acc[m][n], 0, 0, 0);
        }
    }
#undef GT_ISSUE
    if (SSQ) {
#pragma unroll
        for (int m = 0; m < 4; ++m) { ssq[m] += __shfl_xor(ssq[m], 16); ssq[m] += __shfl_xor(ssq[m], 32); }
    }
}

DI void row_load(const float* p, int lane, float (&v)[16]) {
#pragma unroll
    for (int i = 0; i < 4; ++i) { const f32x4 t = *(const f32x4*)(p + lane * 4 + i * 256); v[4 * i] = t[0]; v[4 * i + 1] = t[1]; v[4 * i + 2] = t[2]; v[4 * i + 3] = t[3]; }
}
DI void row_store(float* p, int lane, const float (&v)[16]) {
#pragma unroll
    for (int i = 0; i < 4; ++i) *(f32x4*)(p + lane * 4 + i * 256) = (f32x4){v[4 * i], v[4 * i + 1], v[4 * i + 2], v[4 * i + 3]};
}
DI void row_store_bf16(bf16_t* p, int lane, const float (&v)[16]) {
#pragma unroll
    for (int i = 0; i < 4; ++i) *(u32x2*)(p + lane * 4 + i * 256) = (u32x2){cvtpk(v[4 * i], v[4 * i + 1]), cvtpk(v[4 * i + 2], v[4 * i + 3])};
}
DI void row_ln(float (&v)[16]) {
    float s = 0.f;
#pragma unroll
    for (int i = 0; i < 16; ++i) s += v[i];
    const float mu = wave_sum(s) * (1.f / 1024.f);
    float q = 0.f;
#pragma unroll
    for (int i = 0; i < 16; ++i) { v[i] -= mu; q = fmaf(v[i], v[i], q); }
    const float rs = rsqrtf(wave_sum(q) * (1.f / 1024.f) + EPS);
#pragma unroll
    for (int i = 0; i < 16; ++i) v[i] *= rs;
}

DI void cvt_tile(const Frame& F, const float* src, int ldsrc, int N, int k0, int n0, bf16_t* dst, int lddst, int dmode, const float* scale) {
    LAS float* T = (LAS float*)F.lds;
    const int tid = F.tid;
    {
        const int r = tid >> 4, c4 = (tid & 15) * 4;
#pragma unroll
        for (int hh = 0; hh < 2; ++hh) {
            const int k = r + hh * 32, n = n0 + c4;
            f32x4 v = (f32x4){0.f, 0.f, 0.f, 0.f};
            if (n < N) v = *(const f32x4*)(src + (size_t)(k0 + k) * ldsrc + n);
            if (scale) { const float s = scale[k0 + k]; v = v * s; }
            T[k * 65 + c4 + 0] = v[0]; T[k * 65 + c4 + 1] = v[1]; T[k * 65 + c4 + 2] = v[2]; T[k * 65 + c4 + 3] = v[3];
        }
    }
    __syncthreads();
    {
        const int n = tid >> 3, k8 = (tid & 7) * 8;
        float v[8];
#pragma unroll
        for (int j = 0; j < 8; ++j) v[j] = T[(k8 + j) * 65 + n];
        const int nn = n0 + n;
        const int drow = dmode == 0 ? nn : (32 * (nn >> 4) + (nn & 15) + (dmode == 2 ? 16 : 0));
        *(u32x4*)(dst + (size_t)drow * lddst + k0 + k8) = (u32x4){cvtpk(v[0], v[1]), cvtpk(v[2], v[3]), cvtpk(v[4], v[5]), cvtpk(v[6], v[7])};
    }
    __syncthreads();
}
DI void phase_convert(const Frame& F, int l) {
    constexpr int U_WIN = 16 * 44, U_WOUT = 16 * 16, U_WUQ = 4 * 12, U_WUKV = 2 * 16, U_E = 32 * 16 * 8;
    constexpr int O1 = U_WIN, O2 = O1 + U_WOUT, O3 = O2 + U_WUQ, O4 = O3 + U_WUKV, O5 = O4 + U_E, O6 = O5 + U_E, O7 = O6 + U_E;
    for (int u = F.bid; u < O7; u += F.G) {
        if (u < O1) { const int kt = u / 44, ntl = u % 44; cvt_tile(F, inp(F, I_WIN) + (size_t)l * 1024 * INDIM, INDIM, INDIM, kt * 64, ntl * 64, WSP(bf16_t, WS_WIN), 1024, 0, nullptr); }
        else if (u < O2) { const int v = u - O1, kt = v / 16, ntl = v % 16; cvt_tile(F, inp(F, I_WOUT) + (size_t)l * 1024 * 1024, 1024, 1024, kt * 64, ntl * 64, WSP(bf16_t, WS_WOUT), 1024, 0, nullptr); }
        else if (u < O3) { const int v = u - O2, kt = v / 12, ntl = v % 12; cvt_tile(F, inp(F, I_WUQ) + (size_t)l * 256 * 768, 768, 768, kt * 64, ntl * 64, WSP(bf16_t, WS_WUQ), 256, 0, inp(F, I_QNG) + l * 256); }
        else if (u < O4) { const int v = u - O3, kt = v / 16, ntl = v % 16; cvt_tile(F, inp(F, I_WUKV) + (size_t)l * 128 * 1024, 1024, 1024, kt * 64, ntl * 64, WSP(bf16_t, WS_WUKV), 128, 0, inp(F, I_KVNG) + l * 128); }
        else if (u < O5) { const int v = u - O4, e = v / 128, w = v % 128, kt = w / 8, ntl = w % 8;
            cvt_tile(F, inp(F, I_EW1) + ((size_t)l * NEXP + e) * 1024 * 512, 512, 512, kt * 64, ntl * 64, WSP(bf16_t, WS_W13) + (size_t)e * 1024 * 1024, 1024, 1, nullptr); }
        else if (u < O6) { const int v = u - O5, e = v / 128, w = v % 128, kt = w / 8, ntl = w % 8;
            cvt_tile(F, inp(F, I_EW3) + ((size_t)l * NEXP + e) * 1024 * 512, 512, 512, kt * 64, ntl * 64, WSP(bf16_t, WS_W13) + (size_t)e * 1024 * 1024, 1024, 2, nullptr); }
        else { const int v = u - O6, e = v / 128, w = v % 128, kt = w / 16, ntl = w % 16;
            cvt_tile(F, inp(F, I_EW2) + ((size_t)l * NEXP + e) * 512 * 1024, 1024, 1024, kt * 64, ntl * 64, WSP(bf16_t, WS_W2) + (size_t)e * 1024 * 512, 512, 0, nullptr); }
    }
}

DI void phase_setup(const Frame& Fin) {
    PHASE_FRAME(Fin);
    const int tid = F.tid, lane = F.lane, wid = F.wid;
    {
        LAS float* act = (LAS float*)F.lds;
        LAS float* red = (LAS float*)(F.lds + 12288);
        for (int i = tid; i < 3072; i += 512) { const int s = i >> 10, k = i & 1023; const float v = s < 2 ? inp(F, I_C)[s * 1024 + k] : inp(F, I_CCTX)[k]; act[i] = silu_f(v); }
        __syncthreads();
        for (int u = F.bid; u < 96; u += F.G) {
            const int l = u / 24, cg = u % 24, col = cg * 256 + lane * 4;
            const float* W = inp(F, I_WMOD) + (size_t)l * 1024 * 6144 + col;
            f32x4 a0 = (f32x4){0.f, 0.f, 0.f, 0.f}, a1 = a0, a2 = a0;
            for (int k = wid * 128; k < wid * 128 + 128; ++k) {
                const f32x4 w = *(const f32x4*)(W + (size_t)k * 6144);
                a0 += w * act[k]; a1 += w * act[1024 + k]; a2 += w * act[2048 + k];
            }
#pragma unroll
            for (int j = 0; j < 4; ++j) { red[(wid * 3 + 0) * 256 + lane * 4 + j] = a0[j]; red[(wid * 3 + 1) * 256 + lane * 4 + j] = a1[j]; red[(wid * 3 + 2) * 256 + lane * 4 + j] = a2[j]; }
            __syncthreads();
            for (int i = tid; i < 768; i += 512) {
                const int s = i >> 8, c = i & 255;
                float sum = 0.f;
#pragma unroll
                for (int w = 0; w < 8; ++w) sum += red[(w * 3 + s) * 256 + c];
                WSP(float, WS_MOD)[((size_t)l * 3 + s) * 6144 + cg * 256 + c] = sum + inp(F, I_BMOD)[l * 6144 + cg * 256 + c];
            }
            __syncthreads();
        }
    }
    if (F.bid == F.G - 1) {
        for (int i = tid; i < 1024; i += 512) {
            float z[4], mx = -1e30f;
#pragma unroll
            for (int l = 0; l < 4; ++l) { z[l] = inp(F, I_LBLOG)[l * 1024 + i]; mx = fmaxf(mx, z[l]); }
            float e[4], s = 0.f;
#pragma unroll
            for (int l = 0; l < 4; ++l) { e[l] = expf(z[l] - mx); s += e[l]; }
            float c = 0.f;
#pragma unroll
            for (int l = 0; l < 4; ++l) { if (l > 0) c += e[l] / s; WSP(float, WS_LB)[l * 1024 + i] = c; }
        }
    }
    {
        const int i = F.bid * 512 + tid;
        for (int idx = i; idx < 8192 * 16; idx += F.G * 512) {
            const int t = idx >> 4, ax = (idx >> 3) & 1, f = idx & 7;
            const double fr = f == 0 ? 1.0 : f == 1 ? 0.31622776601683794 : f == 2 ? 0.1 : f == 3 ? 0.031622776601683794 : f == 4 ? 0.01 : f == 5 ? 0.0031622776601683794 : f == 6 ? 0.001 : 0.00031622776601683794;
            const double pos = (double)(ax == 0 ? (t >> 6) : (t & 63));
            const double ang = pos * fr;
            const double n = __builtin_rint(ang * 0.63661977236758134308);
            double r = __builtin_fma(-n, 1.5707963267948966192, ang);
            r = __builtin_fma(-n, 6.123233995736766036e-17, r);
            const double r2 = r * r;
            double sp = 1.0 / 6227020800.0; sp = sp * r2 - 1.0 / 39916800.0; sp = sp * r2 + 1.0 / 362880.0; sp = sp * r2 - 1.0 / 5040.0; sp = sp * r2 + 1.0 / 120.0; sp = sp * r2 - 1.0 / 6.0; sp = sp * r2 + 1.0;
            const double sn = r * sp;
            double cp = -1.0 / 87178291200.0; cp = cp * r2 + 1.0 / 479001600.0; cp = cp * r2 - 1.0 / 3628800.0; cp = cp * r2 + 1.0 / 40320.0; cp = cp * r2 - 1.0 / 720.0; cp = cp * r2 + 1.0 / 24.0; cp = cp * r2 - 0.5; cp = cp * r2 + 1.0;
            const int qd = ((int)n) & 3;
            double cs, ss;
            if (qd == 0) { cs = cp; ss = sn; } else if (qd == 1) { cs = -sn; ss = cp; } else if (qd == 2) { cs = -cp; ss = -sn; } else { cs = sn; ss = -cp; }
            WSP(float, WS_ROPE)[idx] = (float)cs;
            WSP(float, WS_ROPE)[8192 * 16 + idx] = (float)ss;
        }
    }
    phase_convert(F, 0);
}

DI void phase_mod0(const Frame& Fin) {
    PHASE_FRAME(Fin);
    const int lane = F.lane;
    for (int row = F.bid * 8 + F.wid; row < NTOK; row += F.G * 8) {
        float v[16]; row_load(x_in_row(F, 0, row), lane, v); row_ln(v);
        const float* md = WSP(const float, WS_MOD) + (size_t)(0 * 3 + row_seq(row)) * 6144;
        float sh[16], sc[16]; row_load(md, lane, sh); row_load(md + 1024, lane, sc);
#pragma unroll
        for (int i = 0; i < 16; ++i) v[i] = fmaf(v[i], 1.f + sc[i], sh[i]);
        row_store_bf16(WSP(bf16_t, WS_H) + (size_t)row * DM, lane, v);
    }
}

DI void gate_gk(float z, float lb, float& g, float& k) {
    k = (1.f - lb) / (1.f + expf(z));
    g = fmaxf((k < 0.5f) ? log1pf(-k) : logf(1.f - k), -80.f);
}
DI void phase_proj(const Frame& Fin, int l) {
    PHASE_FRAME(Fin);
    const int wid = F.wid, lane = F.lane, wr = wid >> 1, wc = wid & 1, fr = lane & 15, fq = lane >> 4;
    const float* lbt = WSP(const float, WS_LB) + l * 1024;
    constexpr int NCT = INPAD / 128;
    for (int u = F.bid; u < 66 * NCT; u += F.G) {
        const int rt = u / NCT, ct = u % NCT;
        GemmTile g; g.A = WSP(const bf16_t, WS_H); g.lda = 1024; g.rowidx = nullptr; g.nvalid = 0; g.arow0 = (long)rt * 256;
        g.Bt = WSP(const bf16_t, WS_WIN); g.ldb = 1024; g.brow0 = (long)ct * 128; g.K = 1024;
        f32x4 acc[4][4]; float ssq[4];
        gemm_tile<false>(F, g, acc, ssq);
        const int c64 = ct * 128 + wc * 64;
        const size_t row0 = (size_t)rt * 256 + wr * 64 + fr;
#define FOR_MN _Pragma("unroll") for (int m = 0; m < 4; ++m) _Pragma("unroll") for (int n = 0; n < 4; ++n)
#define PKV2(v) (u32x2){cvtpk((v)[0], (v)[1]), cvtpk((v)[2], (v)[3])}
        if (c64 < 256) { FOR_MN { const f32x4 v = acc[m][n]; *(u32x2*)(WSP(bf16_t, WS_PA) + (row0 + m * 16) * 256 + c64 + n * 16 + fq * 4) = PKV2(v); } }
        else if (c64 < 768) { FOR_MN { const f32x4 v = acc[m][n]; const f32x4 sv = (f32x4){silu_f(v[0]), silu_f(v[1]), silu_f(v[2]), silu_f(v[3])};
            *(u32x2*)(WSP(bf16_t, WS_QH) + (row0 + m * 16) * 512 + (c64 - 256) + n * 16 + fq * 4) = PKV2(sv); } }
        else if (c64 < 1792) {
            const bool bw = c64 >= 1280; const int cb = c64 - (bw ? 1280 : 768);
            float* Gp = WSP(float, bw ? WS_GB : WS_GF);
            const float* lbp = lbt + (bw ? 512 : 0) + cb + fq * 4;
            bf16_t* Kp = WSP(bf16_t, bw ? WS_KBW : WS_KF);
            FOR_MN { const f32x4 v = acc[m][n]; const f32x4 lb = *(const f32x4*)(lbp + n * 16);
                f32x4 gg, kk;
#pragma unroll
                for (int j = 0; j < 4; ++j) { float g_, k_; gate_gk(v[j], lb[j], g_, k_); gg[j] = g_; kk[j] = k_; }
                *(f32x4*)(Gp + (row0 + m * 16) * 512 + cb + n * 16 + fq * 4) = gg;
                *(u32x2*)(Kp + (row0 + m * 16) * 512 + cb + n * 16 + fq * 4) = PKV2(kk); } }
        else if (c64 < 2048) { FOR_MN { const f32x4 v = acc[m][n]; *(u32x2*)(WSP(bf16_t, WS_VH) + (row0 + m * 16) * 256 + (c64 - 1792) + n * 16 + fq * 4) = PKV2(v); } }
        else if (c64 < 2304) { FOR_MN { const f32x4 v = acc[m][n]; const f32x4 sv = (f32x4){silu_f(v[0]), silu_f(v[1]), silu_f(v[2]), silu_f(v[3])};
            *(u32x2*)(WSP(bf16_t, WS_GATE) + (row0 + m * 16) * 256 + (c64 - 2048) + n * 16 + fq * 4) = PKV2(sv); } }
        else if (c64 < INDIM) { FOR_MN { const f32x4 v = acc[m][n]; if (c64 + n * 16 < INDIM) *(u32x2*)(WSP(bf16_t, WS_CQKV) + (row0 + m * 16) * 416 + (c64 - 2304) + n * 16 + fq * 4) = PKV2(v); } }
    }
}

constexpr int HS_QT = 0, HS_KT = 8704, HS_KHT = 17408, HS_VT = 27648, HS_SB = 32768, HS_P = 50176, HS_B31 = 52736, HS_END = 53248;
constexpr int HS_LD = 136, HS_LD2 = 40;
DI void hgrn_scan_unit(const Frame& F, int unit) {
    const int tid = F.tid, lane = F.lane, wid = F.wid, fr = lane & 15, fq = lane >> 4;
    LAS unsigned char* L = F.lds;
    LAS bf16_t* QT = (LAS bf16_t*)(L + HS_QT); LAS bf16_t* KT = (LAS bf16_t*)(L + HS_KT); LAS bf16_t* KHT = (LAS bf16_t*)(L + HS_KHT);
    LAS bf16_t* VT = (LAS bf16_t*)(L + HS_VT); LAS bf16_t* SB = (LAS bf16_t*)(L + HS_SB); LAS bf16_t* PP = (LAS bf16_t*)(L + HS_P); LAS float* B31 = (LAS float*)(L + HS_B31);
    const int chain = unit / NSEG, seg = unit % NSEG;
    const int b = chain >> 3, hh = (chain >> 1) & 3, dir = chain & 1;
    const int len = seg == 0 ? 256 : 512, nchunk = len >> 5;
    const int t0 = seg == 0 ? 0 : (dir == 0 ? (seg - 1) * 512 : SEQ - seg * 512);
    const size_t rowbase = seg == 0 ? (size_t)NLAT + b * CTX : (size_t)b * SEQ;
    const float* G = WSP(const float, dir ? WS_GB : WS_GF);
    const bf16_t* KK = WSP(const bf16_t, dir ? WS_KBW : WS_KF);
    const bf16_t* QH = WSP(const bf16_t, WS_QH);
    const bf16_t* VH = WSP(const bf16_t, WS_VH);
    float* OL = WSP(float, WS_OLOC) + (size_t)dir * NTOK * 256;
    bf16_t* QC = WSP(bf16_t, WS_QCUM) + (size_t)dir * NTOK * 512;
    const int dl = lane & 15, tq = lane >> 4, d = wid * 16 + dl;
    __syncthreads();
    for (int i = tid; i < (HS_P - HS_SB) / 4; i += 512) ((LAS unsigned*)(L + HS_SB))[i] = 0u;
    f32x4 accS[4];
#pragma unroll
    for (int et = 0; et < 4; ++et) accS[et] = (f32x4){0.f, 0.f, 0.f, 0.f};
    float B0 = 0.f;
    float gq[8], qq[8], kq[8], vv[4];
#define HS_ROW(p) (rowbase + (size_t)(dir ? (t0 + len - 1 - (p)) : (t0 + (p))))
#define HS_LOAD(c) do { _Pragma("unroll") for (int k = 0; k < 8; ++k) { const size_t r_ = HS_ROW((c) * 32 + tq * 8 + k); \
        gq[k] = G[r_ * 512 + hh * 128 + d]; qq[k] = bf2f(QH[r_ * 512 + hh * 128 + d]); kq[k] = bf2f(KK[r_ * 512 + hh * 128 + d]); } \
        _Pragma("unroll") for (int k = 0; k < 4; ++k) { const size_t r_ = HS_ROW((c) * 32 + wid * 4 + k); vv[k] = bf2f(VH[r_ * 256 + hh * 64 + lane]); } } while (0)
    HS_LOAD(0);
    for (int c = 0; c < nchunk; ++c) {
        {
            float bl[8]; float run = 0.f;
#pragma unroll
            for (int k = 0; k < 8; ++k) { run += gq[k]; bl[k] = run; }
            const float a0 = __shfl(run, dl), a1 = __shfl(run, 16 + dl), a2 = __shfl(run, 32 + dl), a3 = __shfl(run, 48 + dl);
            const float pre = (tq > 0 ? a0 : 0.f) + (tq > 1 ? a1 : 0.f) + (tq > 2 ? a2 : 0.f);
            const float b31 = (a0 + a1) + (a2 + a3);
            const float eB0 = __expf(B0);
            unsigned khp[4];
            float khprev = 0.f;
#pragma unroll
            for (int k = 0; k < 8; ++k) {
                const float bb = pre + bl[k];
                const float qt = qq[k] * __expf(bb);
                const float kt = kq[k] * __expf(fminf(-bb, 80.f));
                const float kh = kq[k] * __expf(b31 - bb);
                const int i = tq * 8 + k;
                QT[i * HS_LD + d] = (bf16_t)f2bf(qt);
                KT[i * HS_LD + d] = (bf16_t)f2bf(kt);
                if (k & 1) khp[k >> 1] = cvtpk(khprev, kh); else khprev = kh;
                QC[HS_ROW(c * 32 + i) * 512 + hh * 128 + d] = (bf16_t)f2bf(qt * eB0);
            }
            *(LAS u32x4*)(KHT + d * HS_LD2 + tq * 8) = (u32x4){khp[0], khp[1], khp[2], khp[3]};
            if (tq == 0) B31[d] = b31;
            *(LAS u32x2*)(VT + lane * HS_LD2 + wid * 4) = (u32x2){cvtpk(vv[0], vv[1]), cvtpk(vv[2], vv[3])};
            B0 += b31;
        }
        if (c + 1 < nchunk) HS_LOAD(c + 1);
        __syncthreads();
        const int it = wid >> 2, et = wid & 3;
        f32x4 accO = (f32x4){0.f, 0.f, 0.f, 0.f};
        {
            const int pit = wid >> 1, pjt = wid & 1;
            f32x4 accP = (f32x4){0.f, 0.f, 0.f, 0.f};
#pragma unroll
            for (int ks = 0; ks < 4; ++ks) {
                const bf16x8 qf = *(const LAS bf16x8*)(QT + (it * 16 + fr) * HS_LD + ks * 32 + fq * 8);
                const bf16x8 sf = *(const LAS bf16x8*)(SB + (et * 16 + fr) * HS_LD + ks * 32 + fq * 8);
                accO = __builtin_amdgcn_mfma_f32_16x16x32_bf16(sf, qf, accO, 0, 0, 0);
                if (wid < 4) {
                    const bf16x8 kf = *(const LAS bf16x8*)(KT + (pjt * 16 + fr) * HS_LD + ks * 32 + fq * 8);
                    const bf16x8 qf2 = *(const LAS bf16x8*)(QT + (pit * 16 + fr) * HS_LD + ks * 32 + fq * 8);
                    accP = __builtin_amdgcn_mfma_f32_16x16x32_bf16(kf, qf2, accP, 0, 0, 0);
                }
            }
            if (wid < 4) {
                const int i = pit * 16 + fr, j0 = pjt * 16 + fq * 4;
                float pv[4];
#pragma unroll
                for (int r = 0; r < 4; ++r) pv[r] = (j0 + r <= i) ? accP[r] : 0.f;
                *(LAS u32x2*)(PP + i * HS_LD2 + j0) = (u32x2){cvtpk(pv[0], pv[1]), cvtpk(pv[2], pv[3])};
            }
        }
        __syncthreads();
        {
            const bf16x8 vf = *(const LAS bf16x8*)(VT + (et * 16 + fr) * HS_LD2 + fq * 8);
            const bf16x8 pf = *(const LAS bf16x8*)(PP + (it * 16 + fr) * HS_LD2 + fq * 8);
            accO = __builtin_amdgcn_mfma_f32_16x16x32_bf16(vf, pf, accO, 0, 0, 0);
            *(f32x4*)(OL + HS_ROW(c * 32 + it * 16 + fr) * 256 + hh * 64 + et * 16 + fq * 4) = accO;
            const f32x4 bd = *(const LAS f32x4*)(B31 + wid * 16 + fq * 4);
            const f32x4 dec = (f32x4){__expf(bd[0]), __expf(bd[1]), __expf(bd[2]), __expf(bd[3])};
            const bf16x8 kf = *(const LAS bf16x8*)(KHT + (wid * 16 + fr) * HS_LD2 + fq * 8);
#pragma unroll
            for (int e4 = 0; e4 < 4; ++e4) {
                const bf16x8 vf2 = *(const LAS bf16x8*)(VT + (e4 * 16 + fr) * HS_LD2 + fq * 8);
                accS[e4] = accS[e4] * dec;
                accS[e4] = __builtin_amdgcn_mfma_f32_16x16x32_bf16(kf, vf2, accS[e4], 0, 0, 0);
                *(LAS u32x2*)(SB + (e4 * 16 + fr) * HS_LD + wid * 16 + fq * 4) = (u32x2){cvtpk_c(accS[e4][0], accS[e4][1]), cvtpk_c(accS[e4][2], accS[e4][3])};
            }
        }
        __syncthreads();
    }
#undef HS_LOAD
#undef HS_ROW
    float* SL = WSP(float, WS_SLOC) + ((size_t)chain * NSEG + seg) * 8192;
#pragma unroll
    for (int e4 = 0; e4 < 4; ++e4)
#pragma unroll
        for (int r = 0; r < 4; ++r) SL[(wid * 16 + fq * 4 + r) * 64 + e4 * 16 + fr] = accS[e4][r];
    if (tq == 0) WSP(float, WS_DTOT)[((size_t)chain * NSEG + seg) * 128 + d] = B0;
}

DI void pool_unit(const Frame& F, int l, int u) {
    const int tid = F.tid;
    int b, t0, n; size_t rowbase;
    if (u < 256) { b = u >> 7; t0 = (u & 127) * 64; n = SEQ; rowbase = (size_t)b * SEQ; }
    else { const int uu = u - 256; b = uu >> 2; t0 = (uu & 3) * 64; n = CTX; rowbase = (size_t)NLAT + b * CTX; }
    LAS bf16_t* U = (LAS bf16_t*)F.lds;
    LAS float* PL = (LAS float*)(F.lds + 40960);
    const bf16_t* PA = WSP(const bf16_t, WS_PA);
    __syncthreads();
    for (int i = tid; i < 80 * 32; i += 512) {
        const int r = i >> 5, c8 = (i & 31) * 8, t = t0 - 8 + r;
        u32x4 v = (u32x4){0u, 0u, 0u, 0u};
        if (t >= 0 && t < n) v = *(const u32x4*)(PA + (rowbase + t) * 256 + c8);
        *(LAS u32x4*)(U + r * 256 + c8) = v;
    }
    __syncthreads();
    {
        const int c = tid & 255, th = tid >> 8, gi = c >> 6, half = 1 << gi;
        for (int tt = 0; tt < 32; ++tt) {
            const int t = th * 32 + tt, T = t0 + t;
            const int lo = max(T - half, 0), hi = min(T + half, n);
            float s = 0.f;
            for (int x = lo; x < hi; ++x) s += bf2f(U[(x - t0 + 8) * 256 + c]);
            PL[t * 256 + c] = s / (float)(hi - lo) - bf2f(U[(t + 8) * 256 + c]);
        }
    }
    __syncthreads();
    {
        const int o = tid & 255, th = tid >> 8, gi = o >> 6, d = o & 63;
        const float* W = inp(F, I_POOLW) + ((size_t)l * 4 + gi) * 4096 + d;
        float acc[32];
#pragma unroll
        for (int tt = 0; tt < 32; ++tt) acc[tt] = 0.f;
        for (int c4 = 0; c4 < 16; ++c4) {
            const float w0 = W[(c4 * 4 + 0) * 64], w1 = W[(c4 * 4 + 1) * 64], w2 = W[(c4 * 4 + 2) * 64], w3 = W[(c4 * 4 + 3) * 64];
#pragma unroll
            for (int tt = 0; tt < 32; ++tt) {
                const f32x4 pv = *(const LAS f32x4*)(PL + (th * 32 + tt) * 256 + gi * 64 + c4 * 4);
                acc[tt] = fmaf(pv[0], w0, acc[tt]); acc[tt] = fmaf(pv[1], w1, acc[tt]); acc[tt] = fmaf(pv[2], w2, acc[tt]); acc[tt] = fmaf(pv[3], w3, acc[tt]);
            }
        }
        const float psc = inp(F, I_POOLS)[l * 256 + o];
        bf16_t* MX = WSP(bf16_t, WS_MIX);
#pragma unroll
        for (int tt = 0; tt < 32; ++tt) MX[(rowbase + t0 + th * 32 + tt) * 1024 + o] = (bf16_t)f2bf(acc[tt] * psc);
    }
}

DI void qproj_unit(const Frame& F, int u) {
    const int wid = F.wid, lane = F.lane, wr = wid >> 1, wc = wid & 1, fr = lane & 15, fq = lane >> 4;
    const int rt = u / 6, ct = u % 6;
    GemmTile g; g.A = WSP(const bf16_t, WS_CQKV); g.lda = 416; g.rowidx = nullptr; g.nvalid = 0; g.arow0 = (long)rt * 256;
    g.Bt = WSP(const bf16_t, WS_WUQ); g.ldb = 256; g.brow0 = (long)ct * 128; g.K = 256;
    f32x4 acc[4][4]; float ssq[4];
    gemm_tile<true>(F, g, acc, ssq);
    const float* rc = WSP(const float, WS_ROPE); const float* rs = rc + 8192 * 16;
    bf16_t* QB = WSP(bf16_t, WS_QB);
#pragma unroll
    for (int m = 0; m < 4; ++m) {
        const int row = rt * 256 + wr * 64 + m * 16 + fr;
        const float rn = rsqrtf(ssq[m] * (1.f / 256.f) + EPS);
        int bb, key; bool lat = row < NLAT;
        if (lat) { bb = row >> 13; key = row & 8191; } else { bb = (row - NLAT) >> 8; key = SEQ + ((row - NLAT) & 255); }
#pragma unroll
        for (int n = 0; n < 4; ++n) {
            const int col = ct * 128 + wc * 64 + n * 16, hd = col / 96, dq0 = col - hd * 96;
            f32x4 v = acc[m][n] * rn;
            if (dq0 >= 64) {
                const int ax = (dq0 - 64) >> 4;
                f32x4 pv;
#pragma unroll
                for (int j = 0; j < 4; ++j) pv[j] = __shfl_xor(v[j], 32);
                if (lat) {
                    const int f0 = (fq & 1) * 4;
                    const f32x4 cs = *(const f32x4*)(rc + key * 16 + ax * 8 + f0), sn = *(const f32x4*)(rs + key * 16 + ax * 8 + f0);
                    if (fq < 2) v = v * cs - pv * sn; else v = v * cs + pv * sn;
                }
            }
            *(u32x2*)(QB + (((size_t)bb * 8 + hd) * NKEY + key) * 96 + dq0 + fq * 4) = (u32x2){cvtpk(v[0], v[1]), cvtpk(v[2], v[3])};
        }
    }
}

DI void kvproj_unit(const Frame& F, int u) {
    const int tid = F.tid, wid = F.wid, lane = F.lane, wr = wid >> 1, wc = wid & 1, fr = lane & 15, fq = lane >> 4;
    const int rt = u >> 3, hd = u & 7;
    GemmTile g; g.A = WSP(const bf16_t, WS_CQKV) + 256; g.lda = 416; g.rowidx = nullptr; g.nvalid = 0; g.arow0 = (long)rt * 256;
    g.Bt = WSP(const bf16_t, WS_WUKV); g.ldb = 128; g.brow0 = (long)hd * 128; g.K = 128;
    f32x4 acc[4][4]; float ssq[4];
    gemm_tile<true>(F, g, acc, ssq);
    bf16_t* KB = WSP(bf16_t, WS_KB); bf16_t* VB = WSP(bf16_t, WS_VB);
#pragma unroll
    for (int m = 0; m < 4; ++m) {
        const int row = rt * 256 + wr * 64 + m * 16 + fr;
        const float rn = rsqrtf(ssq[m] * (1.f / 128.f) + EPS);
        int bb, key;
        if (row < NLAT) { bb = row >> 13; key = row & 8191; } else { bb = (row - NLAT) >> 8; key = SEQ + ((row - NLAT) & 255); }
        const size_t kr = ((size_t)bb * 8 + hd) * NKEY + key;
#pragma unroll
        for (int n = 0; n < 4; ++n) {
            const int c = n * 16 + fq * 4;
            const f32x4 v = acc[m][n] * rn;
            const u32x2 pk = (u32x2){cvtpk(v[0], v[1]), cvtpk(v[2], v[3])};
            if (wc == 0) *(u32x2*)(KB + kr * 128 + c) = pk; else *(u32x2*)(VB + kr * 64 + c) = pk;
        }
    }
    {
        const int row = rt * 256 + (tid >> 1), ax = tid & 1;
        const bf16_t* src = WSP(const bf16_t, WS_CQKV) + (size_t)row * 416 + 384 + ax * 16;
        const u32x4 a = *(const u32x4*)src, bq = *(const u32x4*)(src + 8);
        float x1[8], x2[8];
#pragma unroll
        for (int j = 0; j < 4; ++j) { x1[2 * j] = bf2f(a[j] & 0xffffu); x1[2 * j + 1] = bf2f(a[j] >> 16); x2[2 * j] = bf2f(bq[j] & 0xffffu); x2[2 * j + 1] = bf2f(bq[j] >> 16); }
        int bb, key; const bool lat = row < NLAT;
        if (lat) { bb = row >> 13; key = row & 8191; } else { bb = (row - NLAT) >> 8; key = SEQ + ((row - NLAT) & 255); }
        float o1[8], o2[8];
        if (lat) {
            const float* rc = WSP(const float, WS_ROPE) + key * 16 + ax * 8; const float* rs = rc + 8192 * 16;
#pragma unroll
            for (int f = 0; f < 8; ++f) { o1[f] = x1[f] * rc[f] - x2[f] * rs[f]; o2[f] = x2[f] * rc[f] + x1[f] * rs[f]; }
        } else {
#pragma unroll
            for (int f = 0; f < 8; ++f) { o1[f] = x1[f]; o2[f] = x2[f]; }
        }
        bf16_t* dst = KB + (((size_t)bb * 8 + hd) * NKEY + key) * 128;
        *(u32x4*)(dst + 64 + ax * 16) = (u32x4){cvtpk(o1[0], o1[1]), cvtpk(o1[2], o1[3]), cvtpk(o1[4], o1[5]), cvtpk(o1[6], o1[7])};
        *(u32x4*)(dst + 64 + ax * 16 + 8) = (u32x4){cvtpk(o2[0], o2[1]), cvtpk(o2[2], o2[3]), cvtpk(o2[4], o2[5]), cvtpk(o2[6], o2[7])};
        *(u32x4*)(dst + 96 + ax * 16) = (u32x4){0u, 0u, 0u, 0u};
        *(u32x4*)(dst + 96 + ax * 16 + 8) = (u32x4){0u, 0u, 0u, 0u};
    }
}

DI void phase_local(const Frame& Fin, int l) {
    PHASE_FRAME(Fin);
    for (int u = F.bid; u < 16 * NSEG; u += F.G) hgrn_scan_unit(F, (u < 256) ? (u >> 4) * NSEG + 1 + (u & 15) : (u - 256) * NSEG);
    __syncthreads();
    for (int u = F.bid; u < 264; u += F.G) pool_unit(F, l, u);
    __syncthreads();
    for (int u = F.bid; u < 66 * 6; u += F.G) qproj_unit(F, u);
    for (int u = F.bid; u < 66 * 8; u += F.G) kvproj_unit(F, u);
}

constexpr int AT_SHM_V = 64 * 64 * 2, AT_SHM_K = 64 * 128 * 2;
constexpr float AT_SCALE = 0.10206207261596575f;
constexpr float AT_THR = 8.f;
#define KSWZ(row, colB) ((row) * 256 + ((colB) ^ (((row) & 7) << 4)))
#define SBAR() __builtin_amdgcn_sched_barrier(0)
DI int crow(int r, int hi) { return (r & 3) + 8 * (r >> 2) + 4 * hi; }
DI void partialSM(f32x16& p0, f32x16& p1, float& m_reg, float& mn, float& alpha) {
    constexpr float C = AT_SCALE * 1.4426950408889634f;
    float pmax = p0[0];
#pragma unroll
    for (int r = 1; r < 16; ++r) pmax = fmaxf(pmax, p0[r]);
#pragma unroll
    for (int r = 0; r < 16; ++r) pmax = fmaxf(pmax, p1[r]);
    { auto rr = __builtin_amdgcn_permlane32_swap(__float_as_uint(pmax), __float_as_uint(pmax), false, false);
      pmax = fmaxf(__uint_as_float(rr[0]), __uint_as_float(rr[1])); }
    if (__builtin_expect(__all(pmax - m_reg <= AT_THR / AT_SCALE), 1)) { mn = m_reg; alpha = 1.f; }
    else { mn = fmaxf(m_reg, pmax); alpha = __builtin_amdgcn_exp2f((m_reg - mn) * C); m_reg = mn; }
    const float mnC = -mn * C;
#pragma unroll
    for (int r = 0; r < 16; ++r) p0[r] = fmaf(p0[r], C, mnC);
#pragma unroll
    for (int r = 0; r < 16; ++r) p1[r] = fmaf(p1[r], C, mnC);
#pragma unroll
    for (int r = 0; r < 16; ++r) p0[r] = __builtin_amdgcn_exp2f(p0[r]);
}
DI void finishSM(f32x16& p0, f32x16& p1, float alpha, float& l_reg, bf16x8& pa0, bf16x8& pa1, bf16x8& pa2, bf16x8& pa3) {
#pragma unroll
    for (int r = 0; r < 16; ++r) p1[r] = __builtin_amdgcn_exp2f(p1[r]);
    float ps = 0;
#pragma unroll
    for (int r = 0; r < 16; ++r) ps += p0[r];
#pragma unroll
    for (int r = 0; r < 16; ++r) ps += p1[r];
    { auto rr = __builtin_amdgcn_permlane32_swap(__float_as_uint(ps), __float_as_uint(ps), false, false);
      ps = __uint_as_float(rr[0]) + __uint_as_float(rr[1]); }
    l_reg = l_reg * alpha + ps;
#define PK4(P, BASE, OUT) do { unsigned a0 = cvtpk(P[BASE + 0], P[BASE + 1]), a1 = cvtpk(P[BASE + 2], P[BASE + 3]);   \
    unsigned b0 = cvtpk(P[BASE + 4], P[BASE + 5]), b1 = cvtpk(P[BASE + 6], P[BASE + 7]);                              \
    auto r0 = __builtin_amdgcn_permlane32_swap(a0, b0, false, false); auto r1 = __builtin_amdgcn_permlane32_swap(a1, b1, false, false); \
    u32x4 w = {r0[0], r1[0], r0[1], r1[1]}; OUT = __builtin_bit_cast(bf16x8, w); } while (0)
    PK4(p0, 0, pa0); PK4(p0, 8, pa1); PK4(p1, 0, pa2); PK4(p1, 8, pa3);
#undef PK4
}
DI void qkt(f32x16& p0, f32x16& p1, const LAS unsigned char* Ks, const bf16x8* qr, int r32, int hi) {
#pragma unroll
    for (int r = 0; r < 16; ++r) { p0[r] = 0.f; p1[r] = 0.f; }
#pragma unroll
    for (int d0 = 0; d0 < 6; ++d0) { const int cb = (d0 * 16 + hi * 8) * 2;
        const bf16x8 b0 = *(const LAS bf16x8*)(Ks + KSWZ(r32, cb));
        const bf16x8 b1 = *(const LAS bf16x8*)(Ks + KSWZ(32 + r32, cb));
        p0 = __builtin_amdgcn_mfma_f32_32x32x16_bf16(b0, qr[d0], p0, 0, 0, 0);
        p1 = __builtin_amdgcn_mfma_f32_32x32x16_bf16(b1, qr[d0], p1, 0, 0, 0); }
}
DI int v_st(int k, int c) { const int kk = (k & ~0xC) | ((k & 4) << 1) | ((k & 8) >> 1); return ((kk >> 3) * 2 + (c >> 5)) * 512 + ((kk & 7) * 32 + (c & 31)) * 2; }
DI int v_rd_base(int lane) { return ((lane & 3) << 3) | (((lane >> 2) & 3) << 6) | (((lane >> 4) & 1) << 5) | (((lane >> 5) & 1) << 8); }
constexpr int v_rd_off(int d0, int ks, int half) { return d0 * 512 + ks * 2048 + half * 1024; }
template <int OFF> DI s16x4 tr_read(int vb) { s16x4 r; asm volatile("ds_read_b64_tr_b16 %0, %1 offset:%2" : "=&v"(r) : "v"(vb), "i"(OFF) : "memory"); return r; }
template <int D0> DI void pv_one(f32x16& od, int vb, bf16x8 pa0, bf16x8 pa1, bf16x8 pa2, bf16x8 pa3) {
    const s16x4 l0 = tr_read<v_rd_off(D0, 0, 0)>(vb), h0 = tr_read<v_rd_off(D0, 0, 1)>(vb), l1 = tr_read<v_rd_off(D0, 1, 0)>(vb), h1 = tr_read<v_rd_off(D0, 1, 1)>(vb);
    const s16x4 l2 = tr_read<v_rd_off(D0, 2, 0)>(vb), h2 = tr_read<v_rd_off(D0, 2, 1)>(vb), l3 = tr_read<v_rd_off(D0, 3, 0)>(vb), h3 = tr_read<v_rd_off(D0, 3, 1)>(vb);
    asm volatile("s_waitcnt lgkmcnt(0)" ::: "memory"); SBAR();
#define PKV(L, H) (bf16x8){L[0], L[1], L[2], L[3], H[0], H[1], H[2], H[3]}
    od = __builtin_amdgcn_mfma_f32_32x32x16_bf16(pa0, PKV(l0, h0), od, 0, 0, 0);
    od = __builtin_amdgcn_mfma_f32_32x32x16_bf16(pa1, PKV(l1, h1), od, 0, 0, 0);
    od = __builtin_amdgcn_mfma_f32_32x32x16_bf16(pa2, PKV(l2, h2), od, 0, 0, 0);
    od = __builtin_amdgcn_mfma_f32_32x32x16_bf16(pa3, PKV(l3, h3), od, 0, 0, 0);
#undef PKV
}
DI void pv_d0(f32x16* o, int vb, bf16x8 pa0, bf16x8 pa1, bf16x8 pa2, bf16x8 pa3) {
    pv_one<0>(o[0], vb, pa0, pa1, pa2, pa3); pv_one<1>(o[1], vb, pa0, pa1, pa2, pa3);
}
DI void attn_unit(const Frame& F, const bf16_t* __restrict__ Qb, const bf16_t* __restrict__ Kh, const bf16_t* __restrict__ Vh, bf16_t* __restrict__ Ob, int seq) {
    const int tid = F.tid, wid = F.wid, lane = F.lane, r32 = lane & 31, hi = lane >> 5;
    LAS unsigned char* V_lds = F.lds; LAS unsigned char* K_lds = F.lds + 2 * AT_SHM_V;
    LAS float* ws = (LAS float*)(F.lds + 2 * AT_SHM_V + 2 * AT_SHM_K) + wid * 64; LAS float* li_l = ws; LAS float* al_l = ws + 32;
    float m_reg = -1e30f, l_reg = 0;
    f32x16 o[2];
#pragma unroll
    for (int r = 0; r < 16; ++r) { o[0][r] = 0.f; o[1][r] = 0.f; }
    bf16x8 qr[6];
    const bf16_t* Qw = Qb + (size_t)(wid * 32 + r32) * 96 + hi * 8;
#pragma unroll
    for (int d0 = 0; d0 < 6; ++d0) qr[d0] = *(const bf16x8*)(Qw + d0 * 16);
    const int sr = tid >> 4, sc = (tid & 15) * 8;
    const int vk = tid >> 3, vc = (tid & 7) * 8;
    const int vst = v_st(vk, vc);
    const int vb0 = (int)(uintptr_t)V_lds + v_rd_base(lane);
    struct { bf16x8 vs0, ks0, ks1; } sr_[2];
#define SLOAD(i, k0) do { sr_[i].vs0 = *(const bf16x8*)(Vh + (size_t)((k0) + vk) * 64 + vc); \
    sr_[i].ks0 = *(const bf16x8*)(Kh + (size_t)((k0) + sr) * 128 + sc); sr_[i].ks1 = *(const bf16x8*)(Kh + (size_t)((k0) + 32 + sr) * 128 + sc); } while (0)
#define SWRITE(b, i) do { *(LAS bf16x8*)(V_lds + (b) * AT_SHM_V + vst) = sr_[i].vs0; const int kc = sc * 2; \
    *(LAS bf16x8*)(K_lds + (b) * AT_SHM_K + KSWZ(sr, kc)) = sr_[i].ks0; *(LAS bf16x8*)(K_lds + (b) * AT_SHM_K + KSWZ(32 + sr, kc)) = sr_[i].ks1; } while (0)
#define SWAIT() asm volatile("s_waitcnt vmcnt(3)" ::: "memory")
#define RESC(a) do { if (__any((a) < 1.f)) { if (hi == 0) al_l[r32] = (a); asm volatile("s_waitcnt lgkmcnt(0)" ::: "memory"); \
    _Pragma("unroll") for (int d = 0; d < 2; ++d) _Pragma("unroll") for (int r = 0; r < 16; ++r) o[d][r] *= al_l[crow(r, hi)]; } } while (0)
    f32x16 pA0, pA1, pB0, pB1; float mnA, mnB, alA, alB; bf16x8 pa0, pa1, pa2, pa3; const int NT = seq / 64;
    __syncthreads();
    SLOAD(0, 0); asm volatile("s_waitcnt vmcnt(0)" ::: "memory"); SWRITE(0, 0); __syncthreads();
    qkt(pA0, pA1, K_lds, qr, r32, hi); partialSM(pA0, pA1, m_reg, mnA, alA);
    SLOAD(1, 64); if (2 < NT) SLOAD(0, 128);
    SWAIT(); SWRITE(1, 1); __syncthreads();
    for (int j = 1; j + 1 < NT; j += 2) {
        SBAR(); qkt(pB0, pB1, K_lds + AT_SHM_K, qr, r32, hi);
        finishSM(pA0, pA1, alA, l_reg, pa0, pa1, pa2, pa3); SBAR();
        SLOAD(1, (j + 2) * 64); SBAR();
        pv_d0(o, vb0, pa0, pa1, pa2, pa3); partialSM(pB0, pB1, m_reg, mnB, alB);
        __syncthreads(); SWAIT(); SWRITE(0, 0);
        RESC(alB); __syncthreads();
        SBAR(); qkt(pA0, pA1, K_lds, qr, r32, hi);
        finishSM(pB0, pB1, alB, l_reg, pa0, pa1, pa2, pa3); SBAR();
        if (j + 3 < NT) SLOAD(0, (j + 3) * 64); SBAR();
        pv_d0(o, vb0 + AT_SHM_V, pa0, pa1, pa2, pa3); partialSM(pA0, pA1, m_reg, mnA, alA);
        __syncthreads(); SWAIT(); SWRITE(1, 1);
        RESC(alA); __syncthreads();
    }
    SBAR(); qkt(pB0, pB1, K_lds + AT_SHM_K, qr, r32, hi);
    finishSM(pA0, pA1, alA, l_reg, pa0, pa1, pa2, pa3); SBAR();
    pv_d0(o, vb0, pa0, pa1, pa2, pa3); partialSM(pB0, pB1, m_reg, mnB, alB);
    __syncthreads(); RESC(alB);
    finishSM(pB0, pB1, alB, l_reg, pa0, pa1, pa2, pa3); SBAR();
    pv_d0(o, vb0 + AT_SHM_V, pa0, pa1, pa2, pa3);
    if (hi == 0) li_l[r32] = l_reg; asm volatile("s_waitcnt lgkmcnt(0)" ::: "memory");
    float rli[16];
#pragma unroll
    for (int r = 0; r < 16; ++r) rli[r] = __builtin_amdgcn_rcpf(li_l[crow(r, hi)]);
    bf16_t* Ow = Ob + (size_t)(wid * 32) * 1024;
#pragma unroll
    for (int r = 0; r < 16; ++r) { const int orow = crow(r, hi);
#pragma unroll
        for (int d0 = 0; d0 < 2; ++d0) Ow[(size_t)orow * 1024 + d0 * 32 + r32] = (bf16_t)f2bf(o[d0][r] * rli[r]); }
#undef SLOAD
#undef SWRITE
#undef SWAIT
#undef RESC
}

constexpr int HF_LD = 264;
DI void hgrn_fix_unit(const Frame& F, int l, int u) {
    const int tid = F.tid, lane = F.lane, wid = F.wid, fr = lane & 15, fq = lane >> 4;
    const int b = u / (4 * NSEG), hh = (u / NSEG) & 3, seg = u % NSEG;
    LAS bf16_t* SIB = (LAS bf16_t*)F.lds;
    __syncthreads();
    if (seg != 0) {
        for (int dir = 0; dir < 2; ++dir) {
            const int chain = b * 8 + hh * 2 + dir;
            const int sseg = dir == 0 ? seg : NSEG - seg;
            const float* SL = WSP(const float, WS_SLOC) + (size_t)chain * NSEG * 8192;
            const float* DT = WSP(const float, WS_DTOT) + (size_t)chain * NSEG * 128;
#pragma unroll 1
            for (int i = 0; i < 16; ++i) {
                const int idx = tid + i * 512, d = idx >> 6, e = idx & 63;
                float a = 0.f;
                for (int j = 0; j < sseg; ++j) a = fmaf(__expf(DT[j * 128 + d]), a, SL[(size_t)j * 8192 + idx]);
                SIB[e * HF_LD + dir * 128 + d] = (bf16_t)f2bf(a);
            }
        }
    }
    __syncthreads();
    const int len = seg == 0 ? 256 : 512, t0 = seg == 0 ? 0 : (seg - 1) * 512;
    const size_t rowbase = seg == 0 ? (size_t)NLAT + b * CTX : (size_t)b * SEQ;
    const float* OL0 = WSP(const float, WS_OLOC); const float* OL1 = OL0 + (size_t)NTOK * 256;
    const bf16_t* QC0 = WSP(const bf16_t, WS_QCUM);
    for (int tile = wid; tile < (len >> 4); tile += 8) {
        const size_t row = rowbase + t0 + tile * 16 + fr;
        f32x4 acc[4];
#pragma unroll
        for (int et = 0; et < 4; ++et) acc[et] = (f32x4){0.f, 0.f, 0.f, 0.f};
        if (seg != 0) {
#pragma unroll
            for (int ks = 0; ks < 8; ++ks) {
                const bf16x8 qf = *(const bf16x8*)(QC0 + (size_t)(ks >> 2) * NTOK * 512 + row * 512 + hh * 128 + (ks & 3) * 32 + fq * 8);
#pragma unroll
                for (int et = 0; et < 4; ++et) {
                    const bf16x8 sf = *(const LAS bf16x8*)(SIB + (et * 16 + fr) * HF_LD + ks * 32 + fq * 8);
                    acc[et] = __builtin_amdgcn_mfma_f32_16x16x32_bf16(sf, qf, acc[et], 0, 0, 0);
                }
            }
        }
        float ss = 0.f;
#pragma unroll
        for (int et = 0; et < 4; ++et) {
            const f32x4 o0 = *(const f32x4*)(OL0 + row * 256 + hh * 64 + et * 16 + fq * 4), o1 = *(const f32x4*)(OL1 + row * 256 + hh * 64 + et * 16 + fq * 4);
            acc[et] = acc[et] + o0 + o1;
#pragma unroll
            for (int r = 0; r < 4; ++r) ss = fmaf(acc[et][r], acc[et][r], ss);
        }
        ss += __shfl_xor(ss, 16); ss += __shfl_xor(ss, 32);
        const float rs = rsqrtf(ss * (1.f / 64.f) + EPS);
#pragma unroll
        for (int et = 0; et < 4; ++et) {
            const int e0 = hh * 64 + et * 16 + fq * 4;
            const f32x4 ng = *(const f32x4*)(inp(F, I_HGNG) + l * 256 + e0);
            const u32x2 gt = *(const u32x2*)(WSP(const bf16_t, WS_GATE) + row * 256 + e0);
            const float g0 = bf2f(gt[0] & 0xffffu), g1 = bf2f(gt[0] >> 16), g2 = bf2f(gt[1] & 0xffffu), g3 = bf2f(gt[1] >> 16);
            *(u32x2*)(WSP(bf16_t, WS_MIX) + row * 1024 + 256 + e0) = (u32x2){cvtpk(acc[et][0] * rs * ng[0] * g0, acc[et][1] * rs * ng[1] * g1), cvtpk(acc[et][2] * rs * ng[2] * g2, acc[et][3] * rs * ng[3] * g3)};
        }
    }
}

DI void phase_attn(const Frame& Fin, int l) {
    PHASE_FRAME(Fin);
    for (int u = F.bid; u < 528; u += F.G) {
        if (u < 512) {
            const int bh = u >> 5, qb = u & 31, b = bh >> 3, hd = bh & 7;
            const size_t kv0 = (size_t)bh * NKEY;
            attn_unit(F, WSP(const bf16_t, WS_QB) + (kv0 + qb * 256) * 96, WSP(const bf16_t, WS_KB) + kv0 * 128, WSP(const bf16_t, WS_VB) + kv0 * 64,
                      WSP(bf16_t, WS_MIX) + ((size_t)b * SEQ + qb * 256) * 1024 + 512 + hd * 64, NKEY);
        } else {
            const int bh = u - 512, b = bh >> 3, hd = bh & 7;
            const size_t kv0 = (size_t)bh * NKEY + SEQ;
            attn_unit(F, WSP(const bf16_t, WS_QB) + kv0 * 96, WSP(const bf16_t, WS_KB) + kv0 * 128, WSP(const bf16_t, WS_VB) + kv0 * 64,
                      WSP(bf16_t, WS_MIX) + ((size_t)NLAT + b * CTX) * 1024 + 512 + hd * 64, CTX);
        }
    }
    __syncthreads();
    for (int u = F.bid; u < 2 * 4 * NSEG; u += F.G) hgrn_fix_unit(F, l, u);
}

DI void phase_wout(const Frame& Fin) {
    PHASE_FRAME(Fin);
    const int wid = F.wid, lane = F.lane, wr = wid >> 1, wc = wid & 1, fr = lane & 15, fq = lane >> 4;
    for (int u = F.bid; u < 66 * 8; u += F.G) {
        const int rt = u >> 3, ct = u & 7;
        GemmTile g; g.A = WSP(const bf16_t, WS_MIX); g.lda = 1024; g.rowidx = nullptr; g.nvalid = 0; g.arow0 = (long)rt * 256;
        g.Bt = WSP(const bf16_t, WS_WOUT); g.ldb = 1024; g.brow0 = (long)ct * 128; g.K = 1024;
        f32x4 acc[4][4]; float ssq[4];
        gemm_tile<false>(F, g, acc, ssq);
#pragma unroll
        for (int m = 0; m < 4; ++m) {
            const size_t row = (size_t)rt * 256 + wr * 64 + m * 16 + fr;
#pragma unroll
            for (int n = 0; n < 4; ++n) *(f32x4*)(WSP(float, WS_M) + row * 1024 + ct * 128 + wc * 64 + n * 16 + fq * 4) = acc[m][n];
        }
    }
}

DI void phase_ln1_router(const Frame& Fin, int l) {
    PHASE_FRAME(Fin);
    const int tid = F.tid, lane = F.lane;
    LAS float* RW = (LAS float*)F.lds;
    __syncthreads();
    for (int i = tid; i < 1024 * 36; i += 512) {
        const int k = i / 36, c = i % 36;
        RW[c * 1024 + k] = c < 4 ? inp(F, I_RGW)[((size_t)l * 1024 + k) * 4 + c] : inp(F, I_REW)[((size_t)l * 1024 + k) * 32 + (c - 4)];
    }
    __syncthreads();
    unsigned* cnt = WSP(unsigned, WS_CTL) + CW_CNT + l * 32;
    for (int row = F.bid * 8 + F.wid; row < NTOK; row += F.G * 8) {
        const float* md = WSP(const float, WS_MOD) + (size_t)(l * 3 + row_seq(row)) * 6144;
        float v[16], t[16];
        row_load(x_in_row(F, l, row), lane, v);
        row_load(WSP(const float, WS_M) + (size_t)row * DM, lane, t);
        { float g1[16]; row_load(md + 2048, lane, g1);
#pragma unroll
          for (int i = 0; i < 16; ++i) v[i] = fmaf(ALPHA, v[i], g1[i] * t[i]); }
        row_ln(v);
        { float a[16], bb[16]; row_load(inp(F, I_LN1G) + l * 1024, lane, a); row_load(inp(F, I_LN1B) + l * 1024, lane, bb);
#pragma unroll
          for (int i = 0; i < 16; ++i) v[i] = fmaf(v[i], a[i], bb[i]); }
        row_store(WSP(float, WS_X1) + (size_t)row * DM, lane, v);
        row_ln(v);
        { float sh[16], sc[16]; row_load(md + 3072, lane, sh); row_load(md + 4096, lane, sc);
#pragma unroll
          for (int i = 0; i < 16; ++i) v[i] = fmaf(v[i], 1.f + sc[i], sh[i]); }
        row_store_bf16(WSP(bf16_t, WS_H) + (size_t)row * DM, lane, v);
        float lg[36];
#pragma unroll
        for (int c = 0; c < 36; ++c) {
            float s = 0.f;
#pragma unroll
            for (int i = 0; i < 4; ++i) { const f32x4 w = *(const LAS f32x4*)(RW + c * 1024 + lane * 4 + i * 256);
                s = fmaf(v[4 * i], w[0], s); s = fmaf(v[4 * i + 1], w[1], s); s = fmaf(v[4 * i + 2], w[2], s); s = fmaf(v[4 * i + 3], w[3], s); }
            lg[c] = wave_sum(s);
        }
        if (lane == 0) {
            float g[4]; int gs = 0; float gm;
#pragma unroll
            for (int c = 0; c < 4; ++c) g[c] = lg[c] + inp(F, I_RGB)[l * 4 + c];
            gm = g[0];
#pragma unroll
            for (int c = 1; c < 4; ++c) if (g[c] > gm) { gm = g[c]; gs = c; }
            float se = 0.f;
#pragma unroll
            for (int c = 0; c < 4; ++c) se += expf(g[c] - gm);
            const float wg = 1.f / se;
            float e[8];
#pragma unroll
            for (int c = 0; c < 8; ++c) {
                float val = 0.f;
#pragma unroll
                for (int q = 0; q < 4; ++q) val = (gs == q) ? lg[4 + q * 8 + c] : val;
                e[c] = val + inp(F, I_REB)[l * 32 + gs * 8 + c];
            }
            int i0 = 0; float v0 = e[0];
#pragma unroll
            for (int c = 1; c < 8; ++c) if (e[c] > v0) { v0 = e[c]; i0 = c; }
            int i1 = -1; float v1 = -3.0e38f;
#pragma unroll
            for (int c = 0; c < 8; ++c) if (c != i0 && e[c] > v1) { v1 = e[c]; i1 = c; }
            const float p1 = expf(v1 - v0), den = 1.f / (1.f + p1);
            const float w0 = den * wg, w1 = p1 * den * wg;
            const int e0 = gs * 8 + i0, e1 = gs * 8 + i1;
            const unsigned pos0 = atomicAdd(&cnt[e0], 1u), pos1 = atomicAdd(&cnt[e1], 1u);
            WSP(int, WS_LIST)[(size_t)e0 * NTOK + pos0] = row; WSP(float, WS_LISTW)[(size_t)e0 * NTOK + pos0] = w0;
            WSP(int, WS_LIST)[(size_t)e1 * NTOK + pos1] = row; WSP(float, WS_LISTW)[(size_t)e1 * NTOK + pos1] = w1;
            int* ts = WSP(int, WS_TOKSLOT) + (size_t)row * 4; ts[0] = e0; ts[1] = (int)pos0; ts[2] = e1; ts[3] = (int)pos1;
        }
    }
}

DI void moe_bases(const Frame& F, int l, LAS int* base  , LAS int* cnts  ) {
    __syncthreads();
    if (F.tid == 0) {
        const unsigned* cnt = WSP(const unsigned, WS_CTL) + CW_CNT + l * 32;
        int a = 0;
        for (int e = 0; e < 32; ++e) { const int c = (int)cnt[e]; cnts[e] = c; base[e] = a; a += (c + 255) / 256 * 256; }
        base[32] = a;
    }
    __syncthreads();
}

DI void phase_moe_up(const Frame& Fin, int l) {
    PHASE_FRAME(Fin);
    const int wid = F.wid, lane = F.lane, wr = wid >> 1, wc = wid & 1, fr = lane & 15, fq = lane >> 4;
    LAS int* base = (LAS int*)(F.lds + LDS_MAIN + 64); LAS int* cnts = base + 40;
    moe_bases(F, l, base, cnts);
    const int ntile = base[32] / 256;
    for (int u = F.bid; u < ntile * 8; u += F.G) {
        const int rt = u >> 3, ct = u & 7, slot0 = rt * 256;
        int e = 0;
        for (int q = 1; q < 32; ++q) if (slot0 >= base[q]) e = q;
        const int pos0 = slot0 - base[e];
        GemmTile g; g.A = WSP(const bf16_t, WS_H); g.lda = 1024; g.rowidx = WSP(const int, WS_LIST) + (size_t)e * NTOK + pos0; g.nvalid = cnts[e] - pos0; g.arow0 = 0;
        g.Bt = WSP(const bf16_t, WS_W13) + (size_t)e * 1024 * 1024; g.ldb = 1024; g.brow0 = (long)ct * 128; g.K = 1024;
        f32x4 acc[4][4]; float ssq[4];
        gemm_tile<false>(F, g, acc, ssq);
        bf16_t* ACT = WSP(bf16_t, WS_ACT);
#pragma unroll
        for (int m = 0; m < 4; ++m) {
            const size_t slot = (size_t)slot0 + wr * 64 + m * 16 + fr;
#pragma unroll
            for (int pp = 0; pp < 2; ++pp) {
                const f32x4 a = acc[m][2 * pp], bq = acc[m][2 * pp + 1];
                const int hc = 16 * ((ct * 128 + wc * 64) / 32 + pp) + fq * 4;
                *(u32x2*)(ACT + slot * 512 + hc) = (u32x2){cvtpk(silu_f(a[0]) * bq[0], silu_f(a[1]) * bq[1]), cvtpk(silu_f(a[2]) * bq[2], silu_f(a[3]) * bq[3])};
            }
        }
    }
}
DI void phase_moe_down(const Frame& Fin, int l) {
    PHASE_FRAME(Fin);
    const int wid = F.wid, lane = F.lane, wr = wid >> 1, wc = wid & 1, fr = lane & 15, fq = lane >> 4;
    LAS int* base = (LAS int*)(F.lds + LDS_MAIN + 64); LAS int* cnts = base + 40;
    moe_bases(F, l, base, cnts);
    const int ntile = base[32] / 256;
    for (int u = F.bid; u < ntile * 8; u += F.G) {
        const int rt = u >> 3, ct = u & 7, slot0 = rt * 256;
        int e = 0;
        for (int q = 1; q < 32; ++q) if (slot0 >= base[q]) e = q;
        const int pos0 = slot0 - base[e];
        GemmTile g; g.A = WSP(const bf16_t, WS_ACT); g.lda = 512; g.rowidx = nullptr; g.nvalid = 0; g.arow0 = slot0;
        g.Bt = WSP(const bf16_t, WS_W2) + (size_t)e * 1024 * 512; g.ldb = 512; g.brow0 = (long)ct * 128; g.K = 512;
        f32x4 acc[4][4]; float ssq[4];
        gemm_tile<false>(F, g, acc, ssq);
        bf16_t* Y = WSP(bf16_t, WS_Y);
#pragma unroll
        for (int m = 0; m < 4; ++m) {
            const int r = wr * 64 + m * 16 + fr, pos = pos0 + r;
            const float w = pos < cnts[e] ? WSP(const float, WS_LISTW)[(size_t)e * NTOK + pos] : 0.f;
#pragma unroll
            for (int n = 0; n < 4; ++n) {
                const f32x4 v = acc[m][n] * w;
                *(u32x2*)(Y + (size_t)(slot0 + r) * 1024 + ct * 128 + wc * 64 + n * 16 + fq * 4) = (u32x2){cvtpk(v[0], v[1]), cvtpk(v[2], v[3])};
            }
        }
    }
}

DI void row_load_bf16(const bf16_t* p, int lane, float (&v)[16]) {
#pragma unroll
    for (int i = 0; i < 4; ++i) { const u32x2 t = *(const u32x2*)(p + lane * 4 + i * 256); v[4 * i] = bf2f(t[0] & 0xffffu); v[4 * i + 1] = bf2f(t[0] >> 16); v[4 * i + 2] = bf2f(t[1] & 0xffffu); v[4 * i + 3] = bf2f(t[1] >> 16); }
}
DI void phase_ln2(const Frame& Fin, int l) {
    PHASE_FRAME(Fin);
    const int lane = F.lane;
    LAS int* base = (LAS int*)(F.lds + LDS_MAIN + 64); LAS int* cnts = base + 40;
    moe_bases(F, l, base, cnts);
    for (int row = F.bid * 8 + F.wid; row < NTOK; row += F.G * 8) {
        if (l == 3 && row >= NLAT) continue;
        const float* md = WSP(const float, WS_MOD) + (size_t)(l * 3 + row_seq(row)) * 6144;
        const int* ts = WSP(const int, WS_TOKSLOT) + (size_t)row * 4;
        const size_t s0 = (size_t)base[ts[0]] + ts[1], s1 = (size_t)base[ts[2]] + ts[3];
        float v[16], y0[16], y1[16];
        row_load(WSP(const float, WS_X1) + (size_t)row * DM, lane, v);
        row_load_bf16(WSP(const bf16_t, WS_Y) + s0 * 1024, lane, y0);
        row_load_bf16(WSP(const bf16_t, WS_Y) + s1 * 1024, lane, y1);
        { float g2[16]; row_load(md + 5120, lane, g2);
#pragma unroll
          for (int i = 0; i < 16; ++i) v[i] = fmaf(ALPHA, v[i], g2[i] * (y0[i] + y1[i])); }
        row_ln(v);
        { float a[16], bb[16]; row_load(inp(F, I_LN2G) + l * 1024, lane, a); row_load(inp(F, I_LN2B) + l * 1024, lane, bb);
#pragma unroll
          for (int i = 0; i < 16; ++i) v[i] = fmaf(v[i], a[i], bb[i]); }
        if (l == 3) { row_store((float*)(F.out + (size_t)row * DM), lane, v); continue; }
        row_store(WSP(float, WS_X) + (size_t)row * DM, lane, v);
        row_ln(v);
        const float* md2 = WSP(const float, WS_MOD) + (size_t)((l + 1) * 3 + row_seq(row)) * 6144;
        { float sh[16], sc[16]; row_load(md2, lane, sh); row_load(md2 + 1024, lane, sc);
#pragma unroll
          for (int i = 0; i < 16; ++i) v[i] = fmaf(v[i], 1.f + sc[i], sh[i]); }
        row_store_bf16(WSP(bf16_t, WS_H) + (size_t)row * DM, lane, v);
    }
    if (l < 3) { __syncthreads(); phase_convert(F, l + 1); }
}

constexpr int N_STEPS = 2 + 4 * 8;
__global__ void __launch_bounds__(512, 2) mega(Params P) {
    extern __shared__ __attribute__((aligned(16))) unsigned char lds_raw[];
    Frame F;
    F.in = (kin_t)__builtin_amdgcn_kernarg_segment_ptr();
    F.out = (GAS float*)P.out; F.ws = (GAS unsigned char*)P.ws; F.lds = (LAS unsigned char*)lds_raw;
    F.tid = threadIdx.x; F.lane = F.tid & 63; F.wid = __builtin_amdgcn_readfirstlane(F.tid >> 6); F.G = gridDim.x; F.bid = blockIdx.x;
    const int s_lo = P.s_lo, s_hi = P.s_hi;
    if (F.tid < 64) ((LAS unsigned*)(F.lds + LDS_MAIN))[F.tid] = 0u;
    __syncthreads();
    XcdBarrier bar; bar.bar = WSP(unsigned, WS_CTL) + CW_BAR; bar.x = 0; bar.st = (volatile LAS unsigned*)(F.lds + LDS_MAIN);
    if (s_hi - s_lo > 1) bar = xcd_barrier_post(WSP(unsigned, WS_CTL) + CW_BAR, (volatile LAS unsigned*)(F.lds + LDS_MAIN));
#if defined(EXCL_PH)
#define PH_ON(k) ((k) != EXCL_PH)
#elif !defined(ONLY_PH)
#define PH_ON(k) true
#else
#define PH_ON(k) ((k) == ONLY_PH)
#endif
#define STEP(s) (s_lo <= (s) && (s) < s_hi)
#define SEAM(s) do { if (STEP(s) && STEP((s) + 1)) xcd_barrier(bar); } while (0)
    if (STEP(0) && PH_ON(0)) phase_setup(F);
    SEAM(0);
    if (STEP(1) && PH_ON(1)) phase_mod0(F);
    SEAM(1);
#pragma unroll 1
    for (int l = 0; l < 4; ++l) {
        const int sb = 2 + l * 8;
        if (STEP(sb + 0) && PH_ON(2)) phase_proj(F, l);
        SEAM(sb + 0);
        if (STEP(sb + 1) && PH_ON(3)) phase_local(F, l);
        SEAM(sb + 1);
        if (STEP(sb + 2) && PH_ON(4)) phase_attn(F, l);
        SEAM(sb + 2);
        if (STEP(sb + 3) && PH_ON(5)) phase_wout(F);
        SEAM(sb + 3);
        if (STEP(sb + 4) && PH_ON(6)) phase_ln1_router(F, l);
        SEAM(sb + 4);
        if (STEP(sb + 5) && PH_ON(7)) phase_moe_up(F, l);
        SEAM(sb + 5);
        if (STEP(sb + 6) && PH_ON(8)) phase_moe_down(F, l);
        SEAM(sb + 6);
        if (STEP(sb + 7) && PH_ON(9)) phase_ln2(F, l);
        SEAM(sb + 7);
    }
}

extern "C" void kernel_launch(void* const* d_in, const int* in_sizes, int n_in, void* d_out, int out_size, void* d_ws, size_t ws_size, hipStream_t stream) {
    static int grid = 0;
    if (grid == 0) {
        if (n_in != 27 || out_size != NLAT * DM || ws_size < WS_END) {
            fprintf(stderr, "kernel_launch: shape mismatch: n_in %d out %d ws %zu (need %zu)\n", n_in, out_size, ws_size, (size_t)WS_END); grid = -1; return; }
        int dev = 0, cus = 0, per_cu = 0;
        if (hipGetDevice(&dev) != hipSuccess || hipDeviceGetAttribute(&cus, hipDeviceAttributeMultiprocessorCount, dev) != hipSuccess) { grid = -1; return; }
        if (hipFuncSetAttribute((const void*)mega, hipFuncAttributeMaxDynamicSharedMemorySize, LDS_BYTES) != hipSuccess) { fprintf(stderr, "kernel_launch: hipFuncSetAttribute failed\n"); grid = -1; return; }
        if (hipOccupancyMaxActiveBlocksPerMultiprocessor(&per_cu, (const void*)mega, 512, LDS_BYTES) != hipSuccess || per_cu < 1) fprintf(stderr, "kernel_launch: occupancy query says %d\n", per_cu);
        (void)hipGetLastError();
        grid = cus;
    }
    if (grid < 0) return;
    if (hipMemsetAsync((char*)d_ws + WS_CTL, 0, CTL_BYTES, stream) != hipSuccess) return;
    Params p{};
    for (int i = 0; i < 27; ++i) p.in[i] = (const float*)d_in[i];
    p.out = (float*)d_out; p.ws = (unsigned char*)d_ws;
#if MK_MULTI
    for (int s = 0; s < N_STEPS; ++s) { p.s_lo = s; p.s_hi = s + 1; hipLaunchKernelGGL(mega, dim3(grid), dim3(512), LDS_BYTES, stream, p); }
#else
    p.s_lo = 0; p.s_hi = N_STEPS;
    hipLaunchKernelGGL(mega, dim3(grid), dim3(512), LDS_BYTES, stream, p);
#endif
    const hipError_t le = hipPeekAtLastError();
    if (le != hipSuccess) fprintf(stderr, "kernel_launch: launch failed: %s\n", hipGetErrorName(le));
}
```

```cpp
#include <hip/hip_runtime.h>
#include <cstdio>
#include <cstdint>

#ifndef MK_MULTI
#define MK_MULTI 0
#endif

typedef unsigned short bf16_t;
typedef short bf16x8 __attribute__((ext_vector_type(8)));
typedef short s16x4 __attribute__((ext_vector_type(4)));
typedef float f32x4 __attribute__((ext_vector_type(4)));
typedef float f32x16 __attribute__((ext_vector_type(16)));
typedef unsigned u32x4 __attribute__((ext_vector_type(4)));
typedef unsigned u32x2 __attribute__((ext_vector_type(2)));
#define LAS __attribute__((address_space(3)))
#define DI __device__ __forceinline__

DI unsigned f2bf(float f) { unsigned u = __float_as_uint(f); return (u + 0x7fffu + ((u >> 16) & 1u)) >> 16; }
DI float bf2f(unsigned h) { return __uint_as_float(h << 16); }
typedef float f32x2_t __attribute__((ext_vector_type(2)));
typedef __bf16 bf16x2_t __attribute__((ext_vector_type(2)));
DI unsigned cvtpk_c(float lo, float hi) { const f32x2_t v = {lo, hi}; const bf16x2_t b = __builtin_convertvector(v, bf16x2_t); return __builtin_bit_cast(unsigned, b); }
DI unsigned cvtpk(float lo, float hi) { unsigned r; asm volatile("v_cvt_pk_bf16_f32 %0, %1, %2" : "=v"(r) : "v"(lo), "v"(hi)); return r; }
DI float silu_f(float x) { return x / (1.f + __expf(-x)); }
DI float wave_sum(float v) {
#pragma unroll
    for (int o = 32; o >= 1; o >>= 1) v += __shfl_xor(v, o);
    return v;
}

constexpr int NLAT = 16384, NCTXT = 512, NTOK = 16896, DM = 1024, SEQ = 8192, CTX = 256, NKEY = 8448;
constexpr int INDIM = 2720, INPAD = 2816;
constexpr int NEXP = 32, DEXP = 512;
constexpr int NSLOT = 41984;
constexpr float EPS = 1e-6f;
constexpr float ALPHA = 1.6817928305074290f;
constexpr int NSEG = 17;

constexpr size_t al256(size_t x) { return (x + 255) / 256 * 256; }
constexpr size_t WS_CTL = 0, CTL_BYTES = 1u << 20;
constexpr size_t WS_MOD = WS_CTL + CTL_BYTES;
constexpr size_t WS_LB = WS_MOD + al256(4 * 3 * 6144 * 4);
constexpr size_t WS_ROPE = WS_LB + al256(4 * 2 * 512 * 4);
constexpr size_t WS_X = WS_ROPE + al256(2 * 8192 * 16 * 4);
constexpr size_t WS_X1 = WS_X + al256((size_t)NTOK * DM * 4);
constexpr size_t WS_H = WS_X1 + al256((size_t)NTOK * DM * 4);
constexpr size_t WS_PA = WS_H + al256((size_t)NTOK * DM * 2);
constexpr size_t WS_QH = WS_PA + al256((size_t)NTOK * 256 * 2);
constexpr size_t WS_GF = WS_QH + al256((size_t)NTOK * 512 * 2);
constexpr size_t WS_GB = WS_GF + al256((size_t)NTOK * 512 * 4);
constexpr size_t WS_VH = WS_GB + al256((size_t)NTOK * 512 * 4);
constexpr size_t WS_GATE = WS_VH + al256((size_t)NTOK * 256 * 2);
constexpr size_t WS_CQKV = WS_GATE + al256((size_t)NTOK * 256 * 2);
constexpr size_t WS_QB = WS_CQKV + al256((size_t)NTOK * 416 * 2);
constexpr size_t WS_KB = WS_QB + al256((size_t)16 * NKEY * 96 * 2);
constexpr size_t WS_VB = WS_KB + al256((size_t)16 * NKEY * 128 * 2);
constexpr size_t WS_MIX = WS_VB + al256((size_t)16 * NKEY * 64 * 2);
constexpr size_t WS_M = WS_MIX + al256((size_t)NTOK * DM * 2);
constexpr size_t WS_OLOC = WS_M + al256((size_t)NTOK * DM * 4);
constexpr size_t WS_QCUM = WS_OLOC + al256((size_t)2 * NTOK * 256 * 4);
constexpr size_t WS_SLOC = WS_QCUM + al256((size_t)2 * NTOK * 512 * 2);
constexpr size_t WS_DTOT = WS_SLOC + al256((size_t)16 * NSEG * 8192 * 4);
constexpr size_t WS_LIST = WS_DTOT + al256((size_t)16 * NSEG * 128 * 4);
constexpr size_t WS_LISTW = WS_LIST + al256((size_t)NEXP * NTOK * 4);
constexpr size_t WS_TOKSLOT = WS_LISTW + al256((size_t)NEXP * NTOK * 4);
constexpr size_t WS_ACT = WS_TOKSLOT + al256((size_t)NTOK * 16);
constexpr size_t WS_Y = WS_ACT + al256((size_t)NSLOT * 512 * 2);
constexpr size_t WS_WIN = WS_Y + al256((size_t)NSLOT * 1024 * 2);
constexpr size_t WS_WOUT = WS_WIN + al256((size_t)INPAD * 1024 * 2);
constexpr size_t WS_WUQ = WS_WOUT + al256((size_t)1024 * 1024 * 2);
constexpr size_t WS_WUKV = WS_WUQ + al256((size_t)768 * 256 * 2);
constexpr size_t WS_W13 = WS_WUKV + al256((size_t)1024 * 128 * 2);
constexpr size_t WS_W2 = WS_W13 + al256((size_t)NEXP * 1024 * 1024 * 2);
constexpr size_t WS_KF = WS_W2 + al256((size_t)NEXP * 1024 * 512 * 2);
constexpr size_t WS_KBW = WS_KF + al256((size_t)NTOK * 512 * 2);
constexpr size_t WS_END = WS_KBW + al256((size_t)NTOK * 512 * 2);

constexpr int CW_BAR = 4096;
constexpr int CW_CNT = 16384;
constexpr int CW_KMAX = 24576;

constexpr int LDS_MAIN = 147456;
constexpr int LDS_BYTES = LDS_MAIN + 1024;

struct Params {
    const float* in[27];
    float* out;
    unsigned char* ws;
    int s_lo, s_hi;
};
enum { I_X = 0, I_C, I_CTX, I_CCTX, I_WMOD, I_BMOD, I_WIN, I_POOLW, I_POOLS, I_LBLOG, I_HGNG, I_QNG, I_WUQ, I_KVNG, I_WUKV, I_WOUT,
       I_LN1G, I_LN1B, I_LN2G, I_LN2B, I_RGW, I_RGB, I_REW, I_REB, I_EW1, I_EW3, I_EW2 };

#define XB_TMO      128
#define XB_XCNT(j)  (256  + 64 * (j))
#define XB_XSUB(j)  (1280 + 64 * (j))
#define XB_XGEN(j)  (2304 + 64 * (j))
#define XB_TOP      3328
#define XB_TOPGEN   3392
#define XCD_BAR_WORDS 3456
#define XB_SPIN_CAP (1u << 18)

__device__ __forceinline__ unsigned xb_ld(unsigned* p)              { return __hip_atomic_load(p, __ATOMIC_RELAXED, __HIP_MEMORY_SCOPE_AGENT); }
__device__ __forceinline__ unsigned xb_add(unsigned* p, unsigned v) { return __hip_atomic_fetch_add(p, v, __ATOMIC_RELAXED, __HIP_MEMORY_SCOPE_AGENT); }
__device__ __forceinline__ unsigned xb_xcc_id() { return (unsigned)__builtin_amdgcn_s_getreg((3 << 11) | 20) & 0xFu; }
#define XB_SPIN(cond, bar) do { unsigned _sp = 0; while (cond) { __builtin_amdgcn_s_sleep(1); \
    if ((++_sp & 255u) == 0u) { if (xb_ld(&(bar)[XB_TMO])) break; if (_sp > XB_SPIN_CAP) { atomicAdd(&(bar)[XB_TMO], 1u); break; } } } } while (0)

struct XcdBarrier { unsigned* bar; unsigned x; volatile LAS unsigned* st; };

__device__ __forceinline__ XcdBarrier xcd_barrier_post(unsigned* bar, volatile LAS unsigned* st) {
    XcdBarrier b; b.bar = bar; b.x = xb_xcc_id(); b.st = st;
    if (threadIdx.x == 0) (void)xb_add(&bar[XB_XCNT(b.x)], 1u);
    return b;
}
__device__ __forceinline__ void xcd_barrier_complete(unsigned* bar, unsigned x, unsigned& nloc, unsigned& nx) {
    const unsigned G = gridDim.x * gridDim.y * gridDim.z;
    unsigned sum, cnt, mine, sp = 0u;
    for (;;) {
        sum = 0u; cnt = 0u; mine = 0u;
#pragma unroll
        for (unsigned j = 0; j < 16; ++j) { const unsigned c = xb_ld(&bar[XB_XCNT(j)]); sum += c; cnt += (c > 0u) ? 1u : 0u; mine = (j == x) ? c : mine; }
        if (sum == G) break;
        __builtin_amdgcn_s_sleep(1);
        if ((++sp & 255u) == 0u) { if (xb_ld(&bar[XB_TMO])) break; if (sp > XB_SPIN_CAP) { atomicAdd(&bar[XB_TMO], 1u); break; } }
    }
    nloc = mine > 0u ? mine : 1u; nx = cnt > 0u ? cnt : 1u;
}
__device__ __forceinline__ void xcd_barrier(const XcdBarrier& b) {
    asm volatile("s_waitcnt vmcnt(0)" ::: "memory");
    __syncthreads();
    if (threadIdx.x == 0) {
        unsigned* bar = b.bar;
        __builtin_amdgcn_s_waitcnt(0);
        unsigned nloc = b.st[0], nx = b.st[1];
        if (nloc == 0u) { xcd_barrier_complete(bar, b.x, nloc, nx); b.st[0] = nloc; b.st[1] = nx; }
        const unsigned old = xb_add(&bar[XB_XSUB(b.x)], 1u);
        const unsigned gen = old / nloc;
        if (old + 1u == (gen + 1u) * nloc) {
            __builtin_amdgcn_fence(__ATOMIC_RELEASE, "agent");
            asm volatile("s_waitcnt vmcnt(0)" ::: "memory");
            const unsigned og = xb_add(&bar[XB_TOP], 1u);
            const unsigned tg = og / nx;
            if (og + 1u == (tg + 1u) * nx) xb_add(&bar[XB_TOPGEN], 1u);
            else XB_SPIN(xb_ld(&bar[XB_TOPGEN]) == tg, bar);
            __builtin_amdgcn_fence(__ATOMIC_ACQUIRE, "agent");
            xb_add(&bar[XB_XGEN(b.x)], 1u);
            asm volatile("s_waitcnt vmcnt(0)" ::: "memory");
        } else {
            XB_SPIN(xb_ld(&bar[XB_XGEN(b.x)]) == gen, bar);
            __builtin_amdgcn_fence(__ATOMIC_ACQUIRE, "agent");
            asm volatile("s_waitcnt vmcnt(0)" ::: "memory");
        }
    }
    __syncthreads();
}

#define GAS __attribute__((address_space(1)))
typedef GAS const float* fptr_t;
typedef __attribute__((address_space(4))) const fptr_t* kin_t;
struct Frame {
    kin_t in;
    GAS float* out;
    GAS unsigned char* ws;
    LAS unsigned char* lds;
    int tid, lane, wid, G, bid;
};
#define WSP(T, off) ((T*)(GAS T*)(F.ws + (off)))
DI const float* inp(const Frame& F, int k) { return (const float*)F.in[k]; }
#define PHASE_FRAME(Fin) Frame F = (Fin); { int _w = F.wid; asm volatile("" : "+s"(_w)); int _z = 0; asm volatile("" : "+v"(_z)); \
    F.lane = (int)__builtin_amdgcn_mbcnt_hi(~0u, __builtin_amdgcn_mbcnt_lo(~0u, (unsigned)_z)); F.wid = _w; F.tid = _w * 64 + F.lane; \
    asm volatile("" : "+s"(F.ws), "+s"(F.in), "+s"(F.out)); }

#define PHASE_FRAME2(Fin) Frame F2 = (Fin); { int _w = F2.wid; asm volatile("" : "+s"(_w)); int _z = 0; asm volatile("" : "+v"(_z)); \
    F2.lane = (int)__builtin_amdgcn_mbcnt_hi(~0u, __builtin_amdgcn_mbcnt_lo(~0u, (unsigned)_z)); F2.wid = _w; F2.tid = _w * 64 + F2.lane; }
DI int row_seq(int row) { return row < NLAT ? (row >> 13) : 2; }
DI const float* x_in_row(const Frame& F, int l, int row) {
    if (l == 0) return row < NLAT ? inp(F, I_X) + (size_t)row * DM : inp(F, I_CTX) + (size_t)(row - NLAT) * DM;
    return WSP(const float, WS_X) + (size_t)row * DM;
}

DI int lds_byte(int r, int c) { const int st = (r >> 4) * 2 + (c >> 5), rr = r & 15, cc = c & 31, ob = rr * 64 + cc * 2; return st * 1024 + (ob ^ (((ob >> 9) & 1) << 5)); }
DI void stage_rc(int b, int& R, int& C) { const int st = b / 1024, sb = b % 1024, swz = sb ^ (((sb >> 9) & 1) << 5); R = (st >> 1) * 16 + swz / 64; C = (st & 1) * 32 + (swz % 64) / 2; }

struct GemmTile {
    const bf16_t* A; int lda; const int* rowidx; int nvalid; long arow0;
    const bf16_t* Bt; int ldb; long brow0;
    int K;
};
constexpr int GT_STAGE = 49152;

template <bool SSQ>
DI void gemm_tile(const Frame& F, const GemmTile& g, f32x4 (&acc)[4][4], float (&ssq)[4]) {
    const int tid = F.tid, wid = F.wid, lane = F.lane, wr = wid >> 1, wc = wid & 1, fr = lane & 15, fq = lane >> 4;
    LAS unsigned char* lds = F.lds;
    long aoff[2][2], boff[2];
#pragma unroll
    for (int i = 0; i < 2; ++i) {
        int R, C; stage_rc(tid * 16 + i * 8192, R, C);
#pragma unroll
        for (int h = 0; h < 2; ++h) {
            const int rr = h * 128 + R;
            long grow;
            if (g.rowidx) grow = (rr < g.nvalid) ? (long)g.rowidx[rr] : 0L; else grow = g.arow0 + rr;
            aoff[h][i] = grow * g.lda + C;
        }
        boff[i] = (g.brow0 + R) * g.ldb + C;
    }
#pragma unroll
    for (int m = 0; m < 4; ++m) {
        ssq[m] = 0.f;
#pragma unroll
        for (int n = 0; n < 4; ++n) acc[m][n] = (f32x4){0.f, 0.f, 0.f, 0.f};
    }
    const unsigned ldsw = (unsigned)wid * 1024u;
    const int a_rd = (wr >> 1) * 16384 + lds_byte((wr & 1) * 64 + fr, fq * 8);
    const int b_rd = 32768 + lds_byte(wc * 64 + fr, fq * 8);
#define GT_ISSUE(t, s) do { _Pragma("unroll") for (int _h = 0; _h < 2; ++_h) _Pragma("unroll") for (int _i = 0; _i < 2; ++_i) \
        __builtin_amdgcn_global_load_lds((const unsigned*)(g.A + aoff[_h][_i] + (t) * 64), (LAS unsigned*)(lds + (s) * GT_STAGE + _h * 16384 + ldsw + _i * 8192), 16, 0, 0); \
        _Pragma("unroll") for (int _i = 0; _i < 2; ++_i) \
        __builtin_amdgcn_global_load_lds((const unsigned*)(g.Bt + boff[_i] + (t) * 64), (LAS unsigned*)(lds + (s) * GT_STAGE + 32768 + ldsw + _i * 8192), 16, 0, 0); } while (0)
    const int nt = g.K >> 6;
    __builtin_amdgcn_s_barrier();
    GT_ISSUE(0, 0);
    for (int t = 0; t < nt; ++t) {
        const int cur = t & 1;
        if (t + 1 < nt) {
            __builtin_amdgcn_s_barrier();
            GT_ISSUE(t + 1, cur ^ 1);
            asm volatile("s_waitcnt vmcnt(6)" ::: "memory");
        } else {
            asm volatile("s_waitcnt vmcnt(0)" ::: "memory");
        }
        __builtin_amdgcn_s_barrier();
        LAS unsigned char* sb = lds + cur * GT_STAGE;
#pragma unroll
        for (int ks = 0; ks < 2; ++ks) {
            bf16x8 af[4], bfr[4];
#pragma unroll
            for (int m = 0; m < 4; ++m) af[m] = *(const LAS bf16x8*)(sb + a_rd + m * 2048 + ks * 1024);
#pragma unroll
            for (int n = 0; n < 4; ++n) bfr[n] = *(const LAS bf16x8*)(sb + b_rd + n * 2048 + ks * 1024);
            if (SSQ) {
#pragma unroll
                for (int m = 0; m < 4; ++m)
#pragma unroll
                    for (int j = 0; j < 8; ++j) { const float v = bf2f((unsigned)(unsigned short)af[m][j]); ssq[m] = fmaf(v, v, ssq[m]); }
            }
#pragma unroll
            for (int m = 0; m < 4; ++m)
#pragma unroll
                for (int n = 0; n < 4; ++n) acc[m][n] = __builtin_amdgcn_mfma_f32_16x16x32_bf16(bfr[n], af[m], acc[m][n], 0, 0, 0);
        }
    }
#undef GT_ISSUE
    if (SSQ) {
#pragma unroll
        for (int m = 0; m < 4; ++m) { ssq[m] += __shfl_xor(ssq[m], 16); ssq[m] += __shfl_xor(ssq[m], 32); }
    }
}

DI void row_load(const float* p, int lane, float (&v)[16]) {
#pragma unroll
    for (int i = 0; i < 4; ++i) { const f32x4 t = *(const f32x4*)(p + lane * 4 + i * 256); v[4 * i] = t[0]; v[4 * i + 1] = t[1]; v[4 * i + 2] = t[2]; v[4 * i + 3] = t[3]; }
}
DI void row_store(float* p, int lane, const float (&v)[16]) {
#pragma unroll
    for (int i = 0; i < 4; ++i) *(f32x4*)(p + lane * 4 + i * 256) = (f32x4){v[4 * i], v[4 * i + 1], v[4 * i + 2], v[4 * i + 3]};
}
DI void row_store_bf16(bf16_t* p, int lane, const float (&v)[16]) {
#pragma unroll
    for (int i = 0; i < 4; ++i) *(u32x2*)(p + lane * 4 + i * 256) = (u32x2){cvtpk(v[4 * i], v[4 * i + 1]), cvtpk(v[4 * i + 2], v[4 * i + 3])};
}
DI void row_ln(float (&v)[16]) {
    float s = 0.f;
#pragma unroll
    for (int i = 0; i < 16; ++i) s += v[i];
    const float mu = wave_sum(s) * (1.f / 1024.f);
    float q = 0.f;
#pragma unroll
    for (int i = 0; i < 16; ++i) { v[i] -= mu; q = fmaf(v[i], v[i], q); }
    const float rs = rsqrtf(wave_sum(q) * (1.f / 1024.f) + EPS);
#pragma unroll
    for (int i = 0; i < 16; ++i) v[i] *= rs;
}

struct CvtJob { const float* src; int ldsrc, N, k0, n0; bf16_t* dst; int lddst, dmode; const float* scale; };
DI bool cvt_job(const Frame& F, int l, int u, CvtJob& j) {
    constexpr int U_WIN = 16 * 11, U_WOUT = 16 * 4, U_WUQ = 4 * 3, U_WUKV = 2 * 4, U_E13 = 32 * 16 * 2, U_E2 = 32 * 8 * 4;
    constexpr int O1 = U_WIN, O2 = O1 + U_WOUT, O3 = O2 + U_WUQ, O4 = O3 + U_WUKV, O5 = O4 + U_E13, O6 = O5 + U_E13, O7 = O6 + U_E2;
    if (u >= O7) return false;
    j.scale = nullptr; j.dmode = 0;
    if (u < O1) { j.src = inp(F, I_WIN) + (size_t)l * 1024 * INDIM; j.ldsrc = INDIM; j.N = INDIM; j.k0 = (u / 11) * 64; j.n0 = (u % 11) * 256; j.dst = WSP(bf16_t, WS_WIN); j.lddst = 1024; }
    else if (u < O2) { const int v = u - O1; j.src = inp(F, I_WOUT) + (size_t)l * 1024 * 1024; j.ldsrc = 1024; j.N = 1024; j.k0 = (v / 4) * 64; j.n0 = (v % 4) * 256; j.dst = WSP(bf16_t, WS_WOUT); j.lddst = 1024; }
    else if (u < O3) { const int v = u - O2; j.src = inp(F, I_WUQ) + (size_t)l * 256 * 768; j.ldsrc = 768; j.N = 768; j.k0 = (v / 3) * 64; j.n0 = (v % 3) * 256; j.dst = WSP(bf16_t, WS_WUQ); j.lddst = 256; j.scale = inp(F, I_QNG) + l * 256; }
    else if (u < O4) { const int v = u - O3; j.src = inp(F, I_WUKV) + (size_t)l * 128 * 1024; j.ldsrc = 1024; j.N = 1024; j.k0 = (v / 4) * 64; j.n0 = (v % 4) * 256; j.dst = WSP(bf16_t, WS_WUKV); j.lddst = 128; j.scale = inp(F, I_KVNG) + l * 128; }
    else if (u < O6) { const bool w3 = u >= O5; const int v = u - (w3 ? O5 : O4), e = v / 32, w = v % 32;
        j.src = inp(F, w3 ? I_EW3 : I_EW1) + ((size_t)l * NEXP + e) * 1024 * 512; j.ldsrc = 512; j.N = 512; j.k0 = (w / 2) * 64; j.n0 = (w % 2) * 256; j.dst = WSP(bf16_t, WS_W13) + (size_t)e * 1024 * 1024; j.lddst = 1024; j.dmode = w3 ? 2 : 1; }
    else { const int v = u - O6, e = v / 32, w = v % 32;
        j.src = inp(F, I_EW2) + ((size_t)l * NEXP + e) * 512 * 1024; j.ldsrc = 1024; j.N = 1024; j.k0 = (w / 4) * 64; j.n0 = (w % 4) * 256; j.dst = WSP(bf16_t, WS_W2) + (size_t)e * 1024 * 512; j.lddst = 512; }
    return true;
}
DI void phase_convert(const Frame& F, int l) {
    const int tid = F.tid, lr = tid >> 6, lc4 = (tid & 63) * 4;
    LAS float* T0 = (LAS float*)F.lds;
    f32x4 rg[8];
    CvtJob cj, nj;
    int u = F.bid;
    bool have = cvt_job(F, l, u, cj);
#define CV_LOAD(J) do { _Pragma("unroll") for (int q = 0; q < 8; ++q) { const int k = lr + 8 * q, n = (J).n0 + lc4; f32x4 v = (f32x4){0.f, 0.f, 0.f, 0.f}; \
        if (n < (J).N) v = *(const f32x4*)((J).src + (size_t)((J).k0 + k) * (J).ldsrc + n); if ((J).scale) v = v * (J).scale[(J).k0 + k]; rg[q] = v; } } while (0)
    __syncthreads();
    if (have) CV_LOAD(cj);
    int p = 0;
    while (have) {
        LAS float* T = T0 + p * (64 * 257);
#pragma unroll
        for (int q = 0; q < 8; ++q) { const int k = lr + 8 * q; T[k * 257 + lc4 + 0] = rg[q][0]; T[k * 257 + lc4 + 1] = rg[q][1]; T[k * 257 + lc4 + 2] = rg[q][2]; T[k * 257 + lc4 + 3] = rg[q][3]; }
        u += F.G;
        const bool hn = cvt_job(F, l, u, nj);
        if (hn) CV_LOAD(nj);
        __syncthreads();
        {
            const int n = tid >> 1, kh = (tid & 1) * 32;
            const int nn = cj.n0 + n;
            const int drow = cj.dmode == 0 ? nn : (32 * (nn >> 4) + (nn & 15) + (cj.dmode == 2 ? 16 : 0));
            bf16_t* dp = cj.dst + (size_t)drow * cj.lddst + cj.k0 + kh;
#pragma unroll
            for (int g = 0; g < 4; ++g) {
                float v[8];
#pragma unroll
                for (int jj = 0; jj < 8; ++jj) v[jj] = T[(kh + g * 8 + jj) * 257 + n];
                *(u32x4*)(dp + g * 8) = (u32x4){cvtpk(v[0], v[1]), cvtpk(v[2], v[3]), cvtpk(v[4], v[5]), cvtpk(v[6], v[7])};
            }
        }
        cj = nj; have = hn; p ^= 1;
    }
#undef CV_LOAD
    __syncthreads();
}

DI void phase_setup(const Frame& Fin) {
    PHASE_FRAME(Fin);
    const int tid = F.tid, lane = F.lane, wid = F.wid;
    {
        LAS float* act = (LAS float*)F.lds;
        LAS float* red = (LAS float*)(F.lds + 12288);
        for (int i = tid; i < 3072; i += 512) { const int s = i >> 10, k = i & 1023; const float v = s < 2 ? inp(F, I_C)[s * 1024 + k] : inp(F, I_CCTX)[k]; act[i] = silu_f(v); }
        __syncthreads();
        for (int u = F.bid; u < 96; u += F.G) {
            const int l = u / 24, cg = u % 24, col = cg * 256 + lane * 4;
            const float* W = inp(F, I_WMOD) + (size_t)l * 1024 * 6144 + col;
            f32x4 a0 = (f32x4){0.f, 0.f, 0.f, 0.f}, a1 = a0, a2 = a0;
            for (int k = wid * 128; k < wid * 128 + 128; ++k) {
                const f32x4 w = *(const f32x4*)(W + (size_t)k * 6144);
                a0 += w * act[k]; a1 += w * act[1024 + k]; a2 += w * act[2048 + k];
            }
#pragma unroll
            for (int j = 0; j < 4; ++j) { red[(wid * 3 + 0) * 256 + lane * 4 + j] = a0[j]; red[(wid * 3 + 1) * 256 + lane * 4 + j] = a1[j]; red[(wid * 3 + 2) * 256 + lane * 4 + j] = a2[j]; }
            __syncthreads();
            for (int i = tid; i < 768; i += 512) {
                const int s = i >> 8, c = i & 255;
                float sum = 0.f;
#pragma unroll
                for (int w = 0; w < 8; ++w) sum += red[(w * 3 + s) * 256 + c];
                WSP(float, WS_MOD)[((size_t)l * 3 + s) * 6144 + cg * 256 + c] = sum + inp(F, I_BMOD)[l * 6144 + cg * 256 + c];
            }
            __syncthreads();
        }
    }
    if (F.bid == F.G - 1) {
        for (int i = tid; i < 1024; i += 512) {
            float z[4], mx = -1e30f;
#pragma unroll
            for (int l = 0; l < 4; ++l) { z[l] = inp(F, I_LBLOG)[l * 1024 + i]; mx = fmaxf(mx, z[l]); }
            float e[4], s = 0.f;
#pragma unroll
            for (int l = 0; l < 4; ++l) { e[l] = expf(z[l] - mx); s += e[l]; }
            float c = 0.f;
#pragma unroll
            for (int l = 0; l < 4; ++l) { if (l > 0) c += e[l] / s; WSP(float, WS_LB)[l * 1024 + i] = c; }
        }
    }
    {
        const int i = F.bid * 512 + tid;
        for (int idx = i; idx < 8192 * 16; idx += F.G * 512) {
            const int t = idx >> 4, ax = (idx >> 3) & 1, f = idx & 7;
            const double fr = f == 0 ? 1.0 : f == 1 ? 0.31622776601683794 : f == 2 ? 0.1 : f == 3 ? 0.031622776601683794 : f == 4 ? 0.01 : f == 5 ? 0.0031622776601683794 : f == 6 ? 0.001 : 0.00031622776601683794;
            const double pos = (double)(ax == 0 ? (t >> 6) : (t & 63));
            const double ang = pos * fr;
            const double n = __builtin_rint(ang * 0.63661977236758134308);
            double r = __builtin_fma(-n, 1.5707963267948966192, ang);
            r = __builtin_fma(-n, 6.123233995736766036e-17, r);
            const double r2 = r * r;
            double sp = 1.0 / 6227020800.0; sp = sp * r2 - 1.0 / 39916800.0; sp = sp * r2 + 1.0 / 362880.0; sp = sp * r2 - 1.0 / 5040.0; sp = sp * r2 + 1.0 / 120.0; sp = sp * r2 - 1.0 / 6.0; sp = sp * r2 + 1.0;
            const double sn = r * sp;
            double cp = -1.0 / 87178291200.0; cp = cp * r2 + 1.0 / 479001600.0; cp = cp * r2 - 1.0 / 3628800.0; cp = cp * r2 + 1.0 / 40320.0; cp = cp * r2 - 1.0 / 720.0; cp = cp * r2 + 1.0 / 24.0; cp = cp * r2 - 0.5; cp = cp * r2 + 1.0;
            const int qd = ((int)n) & 3;
            double cs, ss;
            if (qd == 0) { cs = cp; ss = sn; } else if (qd == 1) { cs = -sn; ss = cp; } else if (qd == 2) { cs = -cp; ss = -sn; } else { cs = sn; ss = -cp; }
            WSP(float, WS_ROPE)[idx] = (float)cs;
            WSP(float, WS_ROPE)[8192 * 16 + idx] = (float)ss;
        }
    }
    phase_convert(F, 0);
}

DI void phase_mod0(const Frame& Fin) {
    PHASE_FRAME(Fin);
    const int lane = F.lane;
    for (int row = F.bid * 8 + F.wid; row < NTOK; row += F.G * 8) {
        float v[16]; row_load(x_in_row(F, 0, row), lane, v); row_ln(v);
        const float* md = WSP(const float, WS_MOD) + (size_t)(0 * 3 + row_seq(row)) * 6144;
        float sh[16], sc[16]; row_load(md, lane, sh); row_load(md + 1024, lane, sc);
#pragma unroll
        for (int i = 0; i < 16; ++i) v[i] = fmaf(v[i], 1.f + sc[i], sh[i]);
        row_store_bf16(WSP(bf16_t, WS_H) + (size_t)row * DM, lane, v);
    }
}

namespace g8 {
constexpr int HALF = 128, HTB = 16384;
struct Unit { int pm, pn; const char* A; const char* B; const int* rowidx; int nvalid; };
template <bool GATHER, class Sched, class Epi>
DI void gemm8(const Frame& F, const int K, const Sched& S, const Epi& E) {
    LAS unsigned char* lds = F.lds;
    const int tid = F.tid, wid = F.wid, lane = F.lane, wr = wid >> 2, wc = wid & 3, fr = lane & 15, fq = lane >> 4;
    const int nt = K >> 6;
    unsigned voffA[2][2], nvoffA[2][2], voffB[2];
#pragma unroll
    for (int i = 0; i < 2; ++i) { int sR, sC; stage_rc(tid * 16 + i * 8192, sR, sC); voffB[i] = (unsigned)(sR * K + sC) * 2u; }
    const size_t kstep = 128, hstep = (size_t)HALF * K * 2;
    const unsigned ldsw = (unsigned)wid * 1024u;
    const int aoff = lds_byte(wr * 64 + fr, fq * 8), boff = lds_byte(wc * 32 + fr, fq * 8);
#define G8_SA(b, h) (((b) * 2 + (h)) * HTB)
#define G8_SB(b, h) ((4 + (b) * 2 + (h)) * HTB)
#define G8_STAGE(bufoff, gbase, voff) do { _Pragma("unroll") for (int _i = 0; _i < 2; ++_i) \
        __builtin_amdgcn_global_load_lds((const unsigned*)((const char*)(gbase) + (voff)[_i]), (LAS unsigned*)(lds + (bufoff) + ldsw + _i * 8192), 16, 0, 0); } while (0)
#define G8_LDA(dst, b, h) do { _Pragma("unroll") for (int m = 0; m < 4; ++m) _Pragma("unroll") for (int k = 0; k < 2; ++k) dst[m][k] = *(const LAS bf16x8*)(lds + G8_SA(b, h) + aoff + m * 2048 + k * 1024); } while (0)
#define G8_LDB(dst, b, h) do { _Pragma("unroll") for (int n = 0; n < 2; ++n) _Pragma("unroll") for (int k = 0; k < 2; ++k) dst[n][k] = *(const LAS bf16x8*)(lds + G8_SB(b, h) + boff + n * 2048 + k * 1024); } while (0)
#define G8_MMA(ai, bj, At, Bt) do { __builtin_amdgcn_s_setprio(1); _Pragma("unroll") for (int m = 0; m < 4; ++m) _Pragma("unroll") for (int n = 0; n < 2; ++n) _Pragma("unroll") for (int k = 0; k < 2; ++k) \
        acc[ai][bj][m][n] = __builtin_amdgcn_mfma_f32_16x16x32_bf16(Bt[n][k], At[m][k], acc[ai][bj][m][n], 0, 0, 0); __builtin_amdgcn_s_setprio(0); } while (0)
#define G8_WAIT_V(n) asm volatile("s_waitcnt vmcnt(" #n ")" ::: "memory")
#define G8_WAIT_L(n) asm volatile("s_waitcnt lgkmcnt(" #n ")" ::: "memory")
#define G8_BAR __builtin_amdgcn_s_barrier()
#define G8_SCHED __builtin_amdgcn_sched_barrier(0)
#define G8_VOFF(dst, u) do { int _tz = tid; asm volatile("" : "+v"(_tz)); _Pragma("unroll") for (int _i = 0; _i < 2; ++_i) { int _sR, _sC; stage_rc(_tz * 16 + _i * 8192, _sR, _sC); \
        _Pragma("unroll") for (int _h = 0; _h < 2; ++_h) { const int _rr = _h * HALF + _sR; \
        if (GATHER) { const int _row = (_rr < (u).nvalid) ? (u).rowidx[_rr] : 0; dst[_h][_i] = (unsigned)(_row * K + _sC) * 2u; } else dst[_h][_i] = (unsigned)(_rr * K + _sC) * 2u; } } } while (0)
    Unit cur, nxt; int ui = 0;
    (void)S.next(0, cur);
    f32x4 acc[2][2][4][2];
#define G8_ZERO() do { _Pragma("unroll") for (int a = 0; a < 2; ++a) _Pragma("unroll") for (int b = 0; b < 2; ++b) _Pragma("unroll") for (int m = 0; m < 4; ++m) _Pragma("unroll") for (int n = 0; n < 2; ++n) acc[a][b][m][n] = (f32x4){0.f, 0.f, 0.f, 0.f}; } while (0)
    G8_ZERO();
    bf16x8 At[4][2], B0[2][2], B1[2][2];
    G8_VOFF(voffA, cur);
    const char* cA = cur.A; const char* cB = cur.B;
    __builtin_amdgcn_s_barrier();
    G8_STAGE(G8_SB(0, 0), cB, voffB); G8_STAGE(G8_SB(0, 1), cB + hstep, voffB); G8_STAGE(G8_SA(0, 0), cA, voffA[0]); G8_STAGE(G8_SA(0, 1), cA, voffA[1]);
    if (wr == 1) G8_BAR;
    G8_WAIT_V(2); G8_BAR;
    G8_STAGE(G8_SB(1, 0), cB + kstep, voffB); G8_STAGE(G8_SA(1, 0), cA + kstep, voffA[0]); G8_STAGE(G8_SB(1, 1), cB + hstep + kstep, voffB);
    G8_WAIT_V(6); G8_BAR;
    for (;;) {
        const int has_next = __builtin_amdgcn_readfirstlane(S.next(ui + 1, nxt) ? 1 : 0);
        const char* nA = has_next ? nxt.A : cA; const char* nB = has_next ? nxt.B : cB;
        if (GATHER) { if (has_next) G8_VOFF(nvoffA, nxt); else {
#pragma unroll
            for (int h = 0; h < 2; ++h) { nvoffA[h][0] = voffA[h][0]; nvoffA[h][1] = voffA[h][1]; } } }
        for (int t = 0; t < nt; t += 2) {
            const bool last = (t == nt - 2);
            const char* a1 = cA + (size_t)(t + 1) * kstep;
            const char* a2 = last ? nA : cA + (size_t)(t + 2) * kstep; const char* b2 = last ? nB : cB + (size_t)(t + 2) * kstep;
            const char* a3 = a2 + kstep; const char* b3 = b2 + kstep;
            unsigned vA2[2][2];
#pragma unroll
            for (int h = 0; h < 2; ++h) { vA2[h][0] = (GATHER && last) ? nvoffA[h][0] : voffA[h][0]; vA2[h][1] = (GATHER && last) ? nvoffA[h][1] : voffA[h][1]; }
            G8_LDB(B0, 0, 0); G8_LDB(B1, 0, 1); G8_SCHED; G8_LDA(At, 0, 0); G8_STAGE(G8_SA(1, 1), a1, voffA[1]);
            G8_WAIT_V(8); G8_WAIT_L(0); G8_BAR; G8_MMA(0, 0, At, B0); G8_MMA(0, 1, At, B1); G8_BAR; G8_SCHED;
            G8_LDA(At, 0, 1); G8_STAGE(G8_SB(0, 0), b2, voffB); G8_STAGE(G8_SB(0, 1), b2 + hstep, voffB); G8_STAGE(G8_SA(0, 0), a2, vA2[0]);
            G8_WAIT_V(8); G8_WAIT_L(0); G8_BAR; G8_MMA(1, 0, At, B0); G8_MMA(1, 1, At, B1); G8_BAR; G8_SCHED;
            G8_LDB(B0, 1, 0); G8_LDB(B1, 1, 1); G8_SCHED; G8_LDA(At, 1, 0); G8_STAGE(G8_SA(0, 1), a2, vA2[1]);
            G8_WAIT_V(8); G8_WAIT_L(0); G8_BAR; G8_MMA(0, 0, At, B0); G8_MMA(0, 1, At, B1); G8_BAR; G8_SCHED;
            G8_LDA(At, 1, 1); G8_STAGE(G8_SB(1, 0), b3, voffB); G8_STAGE(G8_SB(1, 1), b3 + hstep, voffB); G8_STAGE(G8_SA(1, 0), a3, vA2[0]);
            G8_WAIT_V(8); G8_WAIT_L(0); G8_BAR; G8_MMA(1, 0, At, B0); G8_MMA(1, 1, At, B1); G8_BAR; G8_SCHED;
        }
        {
            int tz = tid; asm volatile("" : "+v"(tz));
            const int wz = __builtin_amdgcn_readfirstlane(tz >> 6), lz = tz & 63;
            E(acc, cur, wz >> 2, wz & 3, lz & 15, lz >> 4);
        }
        if (!has_next) break;
        G8_ZERO();
        cur = nxt; cA = nA; cB = nB; ++ui;
        if (GATHER) {
#pragma unroll
            for (int h = 0; h < 2; ++h) { voffA[h][0] = nvoffA[h][0]; voffA[h][1] = nvoffA[h][1]; } }
    }
    G8_WAIT_V(0);
    if (wr == 0) G8_BAR;
    G8_BAR;
#undef G8_SA
#undef G8_SB
#undef G8_STAGE
#undef G8_LDA
#undef G8_LDB
#undef G8_MMA
#undef G8_WAIT_V
#undef G8_WAIT_L
#undef G8_BAR
#undef G8_SCHED
#undef G8_VOFF
#undef G8_ZERO
}
struct DenseSched {
    int nM, nN, nwg, G, c; const char* A; const char* B; size_t tstepA, tstepB;
    DI void init(int M, int N, int K, int G_, int c_, const void* A_, const void* B_) { nM = M / 256; nN = N / 256; nwg = nM * nN; G = G_; c = c_; A = (const char*)A_; B = (const char*)B_; tstepA = (size_t)256 * K * 2; tstepB = tstepA; }
    DI bool next(int i, Unit& u) const {
        const long L = (long)i * G + c; if (L >= nwg) return false;
        int wgid = (int)L; { const int q = nwg / 8, r = nwg % 8, xcd = wgid % 8, off = wgid / 8; wgid = (xcd < r ? xcd * (q + 1) : r * (q + 1) + (xcd - r) * q) + off; }
        const int nig = 8 * nN, gid = wgid / nig, fm = gid * 8, gsz = (nM - fm) < 8 ? (nM - fm) : 8;
        u.pm = fm + ((wgid % nig) % gsz); u.pn = (wgid % nig) / gsz; u.A = A + (size_t)u.pm * tstepA; u.B = B + (size_t)u.pn * tstepB; u.rowidx = nullptr; u.nvalid = 0; return true;
    }
};
}

DI void gate_gk(float z, float lb, float& g, float& k) {
    k = (1.f - lb) * __builtin_amdgcn_rcpf(1.f + __expf(z));
    g = fmaxf(__logf(1.f - k), -80.f);
}
#define PKV2(v) (u32x2){cvtpk((v)[0], (v)[1]), cvtpk((v)[2], (v)[3])}
struct EpiProj {
    Frame F; const float* lbt;
#define FOR_AMN _Pragma("unroll") for (int ai = 0; ai < 2; ++ai) _Pragma("unroll") for (int m = 0; m < 4; ++m) _Pragma("unroll") for (int n = 0; n < 2; ++n)
#define ROW_ ((size_t)u.pm * 256 + ai * 128 + wr * 64 + m * 16 + fr)
    template <int bj> DI void half(const f32x4 (&acc)[2][2][4][2], const g8::Unit& u, int wr, int wc, int fr, int fq) const {
        const int c32 = u.pn * 256 + bj * 128 + wc * 32;
        if (c32 < 256) { FOR_AMN { const f32x4 v = acc[ai][bj][m][n] * 1.0f; *(u32x2*)(WSP(bf16_t, WS_PA) + ROW_ * 256 + c32 + n * 16 + fq * 4) = PKV2(v); } }
        else if (c32 < 768) { FOR_AMN { const f32x4 v = acc[ai][bj][m][n]; const f32x4 sv = (f32x4){silu_f(v[0]), silu_f(v[1]), silu_f(v[2]), silu_f(v[3])};
            *(u32x2*)(WSP(bf16_t, WS_QH) + ROW_ * 512 + (c32 - 256) + n * 16 + fq * 4) = PKV2(sv); } }
        else if (c32 < 1792) {
            const bool bw = c32 >= 1280; const int cb = c32 - (bw ? 1280 : 768);
            float* Gp = WSP(float, bw ? WS_GB : WS_GF); bf16_t* Kp = WSP(bf16_t, bw ? WS_KBW : WS_KF);
            const float* lbp = lbt + (bw ? 512 : 0) + cb + fq * 4;
            FOR_AMN { const f32x4 v = acc[ai][bj][m][n]; const f32x4 lb = *(const f32x4*)(lbp + n * 16);
                f32x4 gg, kk;
#pragma unroll
                for (int j = 0; j < 4; ++j) { float g_, k_; gate_gk(v[j], lb[j], g_, k_); gg[j] = g_; kk[j] = k_; }
                *(f32x4*)(Gp + ROW_ * 512 + cb + n * 16 + fq * 4) = gg;
                *(u32x2*)(Kp + ROW_ * 512 + cb + n * 16 + fq * 4) = PKV2(kk); } }
        else if (c32 < 2048) { FOR_AMN { const f32x4 v = acc[ai][bj][m][n] * 1.0f; *(u32x2*)(WSP(bf16_t, WS_VH) + ROW_ * 256 + (c32 - 1792) + n * 16 + fq * 4) = PKV2(v); } }
        else if (c32 < 2304) { FOR_AMN { const f32x4 v = acc[ai][bj][m][n]; const f32x4 sv = (f32x4){silu_f(v[0]), silu_f(v[1]), silu_f(v[2]), silu_f(v[3])};
            *(u32x2*)(WSP(bf16_t, WS_GATE) + ROW_ * 256 + (c32 - 2048) + n * 16 + fq * 4) = PKV2(sv); } }
        else if (c32 < INDIM) { FOR_AMN { const f32x4 v = acc[ai][bj][m][n] * 1.0f; *(u32x2*)(WSP(bf16_t, WS_CQKV) + ROW_ * 416 + (c32 - 2304) + n * 16 + fq * 4) = PKV2(v); } }
    }
    DI void operator()(const f32x4 (&acc)[2][2][4][2], const g8::Unit& u, int wr, int wc, int fr, int fq) const {
        half<0>(acc, u, wr, wc, fr, fq); half<1>(acc, u, wr, wc, fr, fq);
    }
};
DI void phase_proj(const Frame& Fin, int l) {
    PHASE_FRAME(Fin);
    g8::DenseSched S; S.init(NTOK, INPAD, 1024, F.G, F.bid, WSP(const bf16_t, WS_H), WSP(const bf16_t, WS_WIN));
    EpiProj E; E.F = F; E.lbt = WSP(const float, WS_LB) + l * 1024;
    g8::gemm8<false>(F, 1024, S, E);
}

constexpr int HS_QT = 0, HS_KT = 8704, HS_KHT = 17408, HS_VT = 27648, HS_SB = 32768, HS_P = 50176, HS_B31 = 52736, HS_END = 53248;
constexpr int HS_LD = 136, HS_LD2 = 40;
DI void hgrn_scan_unit(const Frame& F, int unit) {
    const int tid = F.tid, lane = F.lane, wid = F.wid, fr = lane & 15, fq = lane >> 4;
    LAS unsigned char* L = F.lds;
    LAS bf16_t* QT = (LAS bf16_t*)(L + HS_QT); LAS bf16_t* KT = (LAS bf16_t*)(L + HS_KT); LAS bf16_t* KHT = (LAS bf16_t*)(L + HS_KHT);
    LAS bf16_t* VT = (LAS bf16_t*)(L + HS_VT); LAS bf16_t* SB = (LAS bf16_t*)(L + HS_SB); LAS bf16_t* PP = (LAS bf16_t*)(L + HS_P); LAS float* B31 = (LAS float*)(L + HS_B31);
    const int chain = unit / NSEG, seg = unit % NSEG;
    const int b = chain >> 3, hh = (chain >> 1) & 3, dir = chain & 1;
    const int len = seg == 0 ? 256 : 512, nchunk = len >> 5;
    const int t0 = seg == 0 ? 0 : (dir == 0 ? (seg - 1) * 512 : SEQ - seg * 512);
    const size_t rowbase = seg == 0 ? (size_t)NLAT + b * CTX : (size_t)b * SEQ;
    const float* G = WSP(const float, dir ? WS_GB : WS_GF);
    const bf16_t* KK = WSP(const bf16_t, dir ? WS_KBW : WS_KF);
    const bf16_t* QH = WSP(const bf16_t, WS_QH);
    const bf16_t* VH = WSP(const bf16_t, WS_VH);
    float* OL = WSP(float, WS_OLOC) + (size_t)dir * NTOK * 256;
    bf16_t* QC = WSP(bf16_t, WS_QCUM) + (size_t)dir * NTOK * 512;
    const int dl = lane & 15, tq = lane >> 4, d = wid * 16 + dl;
    __syncthreads();
    for (int i = tid; i < (HS_P - HS_SB) / 4; i += 512) ((LAS unsigned*)(L + HS_SB))[i] = 0u;
    f32x4 accS[4];
#pragma unroll
    for (int et = 0; et < 4; ++et) accS[et] = (f32x4){0.f, 0.f, 0.f, 0.f};
    float B0 = 0.f;
    float gq[8]; unsigned qq[8], kq[8], vv[4];
#define HS_ROW(p) (rowbase + (size_t)(dir ? (t0 + len - 1 - (p)) : (t0 + (p))))
#define HS_LOAD(c) do { _Pragma("unroll") for (int k = 0; k < 8; ++k) { const size_t r_ = HS_ROW((c) * 32 + tq * 8 + k); \
        gq[k] = G[r_ * 512 + hh * 128 + d]; qq[k] = QH[r_ * 512 + hh * 128 + d]; kq[k] = KK[r_ * 512 + hh * 128 + d]; } \
        _Pragma("unroll") for (int k = 0; k < 4; ++k) { const size_t r_ = HS_ROW((c) * 32 + wid * 4 + k); vv[k] = VH[r_ * 256 + hh * 64 + lane]; } } while (0)
    HS_LOAD(0);
    for (int c = 0; c < nchunk; ++c) {
        {
            float bl[8]; float run = 0.f;
#pragma unroll
            for (int k = 0; k < 8; ++k) { run += gq[k]; bl[k] = run; }
            const float a0 = __shfl(run, dl), a1 = __shfl(run, 16 + dl), a2 = __shfl(run, 32 + dl), a3 = __shfl(run, 48 + dl);
            const float pre = (tq > 0 ? a0 : 0.f) + (tq > 1 ? a1 : 0.f) + (tq > 2 ? a2 : 0.f);
            const float b31 = (a0 + a1) + (a2 + a3);
            const float eB0 = __expf(B0);
            unsigned khp[4];
            float khprev = 0.f;
#pragma unroll
            for (int k = 0; k < 8; ++k) {
                const float bb = pre + bl[k];
                const float qv_ = bf2f(qq[k]), kv_ = bf2f(kq[k]);
                const float qt = qv_ * __expf(bb);
                const float kt = kv_ * __expf(fminf(-bb, 80.f));
                const float kh = kv_ * __expf(b31 - bb);
                const int i = tq * 8 + k;
                QT[i * HS_LD + d] = (bf16_t)f2bf(qt);
                KT[i * HS_LD + d] = (bf16_t)f2bf(kt);
                if (k & 1) khp[k >> 1] = cvtpk(khprev, kh); else khprev = kh;
                QC[HS_ROW(c * 32 + i) * 512 + hh * 128 + d] = (bf16_t)f2bf(qt * eB0);
            }
            *(LAS u32x4*)(KHT + d * HS_LD2 + tq * 8) = (u32x4){khp[0], khp[1], khp[2], khp[3]};
            if (tq == 0) B31[d] = b31;
            *(LAS u32x2*)(VT + lane * HS_LD2 + wid * 4) = (u32x2){vv[0] | (vv[1] << 16), vv[2] | (vv[3] << 16)};
            B0 += b31;
        }
        if (c + 1 < nchunk) HS_LOAD(c + 1);
        __syncthreads();
        const int it = wid >> 2, et = wid & 3;
        f32x4 accO = (f32x4){0.f, 0.f, 0.f, 0.f};
        {
            const int pit = wid >> 1, pjt = wid & 1;
            f32x4 accP = (f32x4){0.f, 0.f, 0.f, 0.f};
#pragma unroll
            for (int ks = 0; ks < 4; ++ks) {
                const bf16x8 qf = *(const LAS bf16x8*)(QT + (it * 16 + fr) * HS_LD + ks * 32 + fq * 8);
                const bf16x8 sf = *(const LAS bf16x8*)(SB + (et * 16 + fr) * HS_LD + ks * 32 + fq * 8);
                accO = __builtin_amdgcn_mfma_f32_16x16x32_bf16(sf, qf, accO, 0, 0, 0);
                if (wid < 4) {
                    const bf16x8 kf = *(const LAS bf16x8*)(KT + (pjt * 16 + fr) * HS_LD + ks * 32 + fq * 8);
                    const bf16x8 qf2 = *(const LAS bf16x8*)(QT + (pit * 16 + fr) * HS_LD + ks * 32 + fq * 8);
                    accP = __builtin_amdgcn_mfma_f32_16x16x32_bf16(kf, qf2, accP, 0, 0, 0);
                }
            }
            if (wid < 4) {
                const int i = pit * 16 + fr, j0 = pjt * 16 + fq * 4;
                float pv[4];
#pragma unroll
                for (int r = 0; r < 4; ++r) pv[r] = (j0 + r <= i) ? accP[r] : 0.f;
                *(LAS u32x2*)(PP + i * HS_LD2 + j0) = (u32x2){cvtpk(pv[0], pv[1]), cvtpk(pv[2], pv[3])};
            }
        }
        __syncthreads();
        {
            const bf16x8 vf = *(const LAS bf16x8*)(VT + (et * 16 + fr) * HS_LD2 + fq * 8);
            const bf16x8 pf = *(const LAS bf16x8*)(PP + (it * 16 + fr) * HS_LD2 + fq * 8);
            accO = __builtin_amdgcn_mfma_f32_16x16x32_bf16(vf, pf, accO, 0, 0, 0);
            *(f32x4*)(OL + HS_ROW(c * 32 + it * 16 + fr) * 256 + hh * 64 + et * 16 + fq * 4) = accO;
            const f32x4 bd = *(const LAS f32x4*)(B31 + wid * 16 + fq * 4);
            const f32x4 dec = (f32x4){__expf(bd[0]), __expf(bd[1]), __expf(bd[2]), __expf(bd[3])};
            const bf16x8 kf = *(const LAS bf16x8*)(KHT + (wid * 16 + fr) * HS_LD2 + fq * 8);
#pragma unroll
            for (int e4 = 0; e4 < 4; ++e4) {
                const bf16x8 vf2 = *(const LAS bf16x8*)(VT + (e4 * 16 + fr) * HS_LD2 + fq * 8);
                accS[e4] = accS[e4] * dec;
                accS[e4] = __builtin_amdgcn_mfma_f32_16x16x32_bf16(kf, vf2, accS[e4], 0, 0, 0);
                *(LAS u32x2*)(SB + (e4 * 16 + fr) * HS_LD + wid * 16 + fq * 4) = (u32x2){cvtpk_c(accS[e4][0], accS[e4][1]), cvtpk_c(accS[e4][2], accS[e4][3])};
            }
        }
        __syncthreads();
    }
#undef HS_LOAD
#undef HS_ROW
    float* SL = WSP(float, WS_SLOC) + ((size_t)chain * NSEG + seg) * 8192;
#pragma unroll
    for (int e4 = 0; e4 < 4; ++e4)
#pragma unroll
        for (int r = 0; r < 4; ++r) SL[(wid * 16 + fq * 4 + r) * 64 + e4 * 16 + fr] = accS[e4][r];
    if (tq == 0) WSP(float, WS_DTOT)[((size_t)chain * NSEG + seg) * 128 + d] = B0;
}

DI void pool_unit(const Frame& F, int l, int u) {
    const int tid = F.tid;
    int b, t0, n; size_t rowbase;
    if (u < 256) { b = u >> 7; t0 = (u & 127) * 64; n = SEQ; rowbase = (size_t)b * SEQ; }
    else { const int uu = u - 256; b = uu >> 2; t0 = (uu & 3) * 64; n = CTX; rowbase = (size_t)NLAT + b * CTX; }
    LAS bf16_t* U = (LAS bf16_t*)F.lds;
    LAS float* PL = (LAS float*)(F.lds + 40960);
    const bf16_t* PA = WSP(const bf16_t, WS_PA);
    __syncthreads();
    for (int i = tid; i < 80 * 32; i += 512) {
        const int r = i >> 5, c8 = (i & 31) * 8, t = t0 - 8 + r;
        u32x4 v = (u32x4){0u, 0u, 0u, 0u};
        if (t >= 0 && t < n) v = *(const u32x4*)(PA + (rowbase + t) * 256 + c8);
        *(LAS u32x4*)(U + r * 256 + c8) = v;
    }
    __syncthreads();
    {
        const int c = tid & 255, th = tid >> 8, gi = c >> 6, half = 1 << gi;
        for (int tt = 0; tt < 32; ++tt) {
            const int t = th * 32 + tt, T = t0 + t;
            const int lo = max(T - half, 0), hi = min(T + half, n);
            float s = 0.f;
            for (int x = lo; x < hi; ++x) s += bf2f(U[(x - t0 + 8) * 256 + c]);
            PL[t * 256 + c] = s / (float)(hi - lo) - bf2f(U[(t + 8) * 256 + c]);
        }
    }
    __syncthreads();
    {
        const int o = tid & 255, th = tid >> 8, gi = o >> 6, d = o & 63;
        const float* W = inp(F, I_POOLW) + ((size_t)l * 4 + gi) * 4096 + d;
        float acc[32];
#pragma unroll
        for (int tt = 0; tt < 32; ++tt) acc[tt] = 0.f;
        for (int c4 = 0; c4 < 16; ++c4) {
            const float w0 = W[(c4 * 4 + 0) * 64], w1 = W[(c4 * 4 + 1) * 64], w2 = W[(c4 * 4 + 2) * 64], w3 = W[(c4 * 4 + 3) * 64];
#pragma unroll
            for (int tt = 0; tt < 32; ++tt) {
                const f32x4 pv = *(const LAS f32x4*)(PL + (th * 32 + tt) * 256 + gi * 64 + c4 * 4);
                acc[tt] = fmaf(pv[0], w0, acc[tt]); acc[tt] = fmaf(pv[1], w1, acc[tt]); acc[tt] = fmaf(pv[2], w2, acc[tt]); acc[tt] = fmaf(pv[3], w3, acc[tt]);
            }
        }
        const float psc = inp(F, I_POOLS)[l * 256 + o];
        bf16_t* MX = WSP(bf16_t, WS_MIX);
#pragma unroll
        for (int tt = 0; tt < 32; ++tt) MX[(rowbase + t0 + th * 32 + tt) * 1024 + o] = (bf16_t)f2bf(acc[tt] * psc);
    }
}

DI void qproj_unit(const Frame& F, int u) {
    const int wid = F.wid, lane = F.lane, wr = wid >> 1, wc = wid & 1, fr = lane & 15, fq = lane >> 4;
    const int rt = u / 6, ct = u % 6;
    GemmTile g; g.A = WSP(const bf16_t, WS_CQKV); g.lda = 416; g.rowidx = nullptr; g.nvalid = 0; g.arow0 = (long)rt * 256;
    g.Bt = WSP(const bf16_t, WS_WUQ); g.ldb = 256; g.brow0 = (long)ct * 128; g.K = 256;
    f32x4 acc[4][4]; float ssq[4];
    gemm_tile<true>(F, g, acc, ssq);
    const float* rc = WSP(const float, WS_ROPE); const float* rs = rc + 8192 * 16;
    bf16_t* QB = WSP(bf16_t, WS_QB);
#pragma unroll
    for (int m = 0; m < 4; ++m) {
        const int row = rt * 256 + wr * 64 + m * 16 + fr;
        const float rn = rsqrtf(ssq[m] * (1.f / 256.f) + EPS);
        int bb, key; bool lat = row < NLAT;
        if (lat) { bb = row >> 13; key = row & 8191; } else { bb = (row - NLAT) >> 8; key = SEQ + ((row - NLAT) & 255); }
#pragma unroll
        for (int n = 0; n < 4; ++n) {
            const int col = ct * 128 + wc * 64 + n * 16, hd = col / 96, dq0 = col - hd * 96;
            f32x4 v = acc[m][n] * rn;
            if (dq0 >= 64) {
                const int ax = (dq0 - 64) >> 4;
                f32x4 pv;
#pragma unroll
                for (int j = 0; j < 4; ++j) pv[j] = __shfl_xor(v[j], 32);
                if (lat) {
                    const int f0 = (fq & 1) * 4;
                    const f32x4 cs = *(const f32x4*)(rc + key * 16 + ax * 8 + f0), sn = *(const f32x4*)(rs + key * 16 + ax * 8 + f0);
                    if (fq < 2) v = v * cs - pv * sn; else v = v * cs + pv * sn;
                }
            }
            *(u32x2*)(QB + (((size_t)bb * 8 + hd) * NKEY + key) * 96 + dq0 + fq * 4) = (u32x2){cvtpk(v[0], v[1]), cvtpk(v[2], v[3])};
        }
    }
}

DI void kvproj_unit(const Frame& F, int l, int u) {
    const int tid = F.tid, wid = F.wid, lane = F.lane, wr = wid >> 1, wc = wid & 1, fr = lane & 15, fq = lane >> 4;
    const int rt = u >> 3, hd = u & 7;
    GemmTile g; g.A = WSP(const bf16_t, WS_CQKV) + 256; g.lda = 416; g.rowidx = nullptr; g.nvalid = 0; g.arow0 = (long)rt * 256;
    g.Bt = WSP(const bf16_t, WS_WUKV); g.ldb = 128; g.brow0 = (long)hd * 128; g.K = 128;
    f32x4 acc[4][4]; float ssq[4];
    gemm_tile<true>(F, g, acc, ssq);
    bf16_t* KB = WSP(bf16_t, WS_KB); bf16_t* VB = WSP(bf16_t, WS_VB);
    float nrm2[4] = {0.f, 0.f, 0.f, 0.f};
#pragma unroll
    for (int m = 0; m < 4; ++m) {
        const int row = rt * 256 + wr * 64 + m * 16 + fr;
        const float rn = rsqrtf(ssq[m] * (1.f / 128.f) + EPS);
        int bb, key;
        if (row < NLAT) { bb = row >> 13; key = row & 8191; } else { bb = (row - NLAT) >> 8; key = SEQ + ((row - NLAT) & 255); }
        const size_t kr = ((size_t)bb * 8 + hd) * NKEY + key;
#pragma unroll
        for (int n = 0; n < 4; ++n) {
            const int c = n * 16 + fq * 4;
            const f32x4 v = acc[m][n] * rn;
            const u32x2 pk = (u32x2){cvtpk(v[0], v[1]), cvtpk(v[2], v[3])};
            if (wc == 0) { *(u32x2*)(KB + kr * 128 + c) = pk; nrm2[m] += v[0] * v[0] + v[1] * v[1] + v[2] * v[2] + v[3] * v[3]; } else *(u32x2*)(VB + kr * 64 + c) = pk;
        }
    }
    unsigned* kmaxw = WSP(unsigned, WS_CTL) + CW_KMAX + (l * 16 + (rt < 64 ? (rt >> 5) : (rt - 64)) * 8 + hd) * 2;
    if (wc == 0) {
        float mx = 0.f;
#pragma unroll
        for (int m = 0; m < 4; ++m) { float t = nrm2[m]; t += __shfl_xor(t, 16); t += __shfl_xor(t, 32); mx = fmaxf(mx, t); }
#pragma unroll
        for (int o = 8; o >= 1; o >>= 1) mx = fmaxf(mx, __shfl_xor(mx, o));
        if (lane == 0) atomicMax(kmaxw, __float_as_uint(mx));
    }
    {
        const int row = rt * 256 + (tid >> 1), ax = tid & 1;
        const bf16_t* src = WSP(const bf16_t, WS_CQKV) + (size_t)row * 416 + 384 + ax * 16;
        const u32x4 a = *(const u32x4*)src, bq = *(const u32x4*)(src + 8);
        float x1[8], x2[8];
#pragma unroll
        for (int j = 0; j < 4; ++j) { x1[2 * j] = bf2f(a[j] & 0xffffu); x1[2 * j + 1] = bf2f(a[j] >> 16); x2[2 * j] = bf2f(bq[j] & 0xffffu); x2[2 * j + 1] = bf2f(bq[j] >> 16); }
        int bb, key; const bool lat = row < NLAT;
        if (lat) { bb = row >> 13; key = row & 8191; } else { bb = (row - NLAT) >> 8; key = SEQ + ((row - NLAT) & 255); }
        float o1[8], o2[8];
        if (lat) {
            const float* rc = WSP(const float, WS_ROPE) + key * 16 + ax * 8; const float* rs = rc + 8192 * 16;
#pragma unroll
            for (int f = 0; f < 8; ++f) { o1[f] = x1[f] * rc[f] - x2[f] * rs[f]; o2[f] = x2[f] * rc[f] + x1[f] * rs[f]; }
        } else {
#pragma unroll
            for (int f = 0; f < 8; ++f) { o1[f] = x1[f]; o2[f] = x2[f]; }
        }
        {
            float t = 0.f;
#pragma unroll
            for (int f = 0; f < 8; ++f) t += o1[f] * o1[f] + o2[f] * o2[f];
            t += __shfl_xor(t, 1);
#pragma unroll
            for (int o = 32; o >= 2; o >>= 1) t = fmaxf(t, __shfl_xor(t, o));
            if (lane == 0) atomicMax(kmaxw + 1, __float_as_uint(t));
        }
        bf16_t* dst = KB + (((size_t)bb * 8 + hd) * NKEY + key) * 128;
        *(u32x4*)(dst + 64 + ax * 16) = (u32x4){cvtpk(o1[0], o1[1]), cvtpk(o1[2], o1[3]), cvtpk(o1[4], o1[5]), cvtpk(o1[6], o1[7])};
        *(u32x4*)(dst + 64 + ax * 16 + 8) = (u32x4){cvtpk(o2[0], o2[1]), cvtpk(o2[2], o2[3]), cvtpk(o2[4], o2[5]), cvtpk(o2[6], o2[7])};
    }
}

DI void phase_local(const Frame& Fin, int l) {
    PHASE_FRAME(Fin);
    const int bid = F.bid;
    hgrn_scan_unit(F, (bid >> 4) * NSEG + 1 + (bid & 15));
    if (bid < 16) hgrn_scan_unit(F, bid * NSEG);
    __syncthreads();
    pool_unit(F, l, bid);
    if (bid >= 16 && bid < 24) pool_unit(F, l, 256 + bid - 16);
    __syncthreads();
    if (bid >= 24) {
        const int j = bid - 24;
        for (int u = j; u < 66 * 6; u += 232) qproj_unit(F, u);
        for (int u = j; u < 66 * 8; u += 232) kvproj_unit(F, l, u);
    }
}

constexpr int AT_SHM_V = 64 * 64 * 2, AT_SHM_K = 64 * 128 * 2;
constexpr float AT_SCALE = 0.10206207261596575f;
constexpr float AT_THR = 8.f;
#define KSWZ(row, colB) ((row) * 256 + ((colB) ^ (((row) & 7) << 4)))
#define SBAR() __builtin_amdgcn_sched_barrier(0)
DI int crow(int r, int hi) { return (r & 3) + 8 * (r >> 2) + 4 * hi; }
DI void partialSM(f32x16& p0, f32x16& p1, float mnC) {
    constexpr float C = AT_SCALE * 1.4426950408889634f;
#pragma unroll
    for (int r = 0; r < 16; ++r) p0[r] = fmaf(p0[r], C, mnC);
#pragma unroll
    for (int r = 0; r < 16; ++r) p1[r] = fmaf(p1[r], C, mnC);
#pragma unroll
    for (int r = 0; r < 16; ++r) p0[r] = __builtin_amdgcn_exp2f(p0[r]);
}
DI void finishSM(f32x16& p0, f32x16& p1, float& l_reg, bf16x8& pa0, bf16x8& pa1, bf16x8& pa2, bf16x8& pa3) {
#pragma unroll
    for (int r = 0; r < 16; ++r) p1[r] = __builtin_amdgcn_exp2f(p1[r]);
    float ps = 0;
#pragma unroll
    for (int r = 0; r < 16; ++r) ps += p0[r];
#pragma unroll
    for (int r = 0; r < 16; ++r) ps += p1[r];
    l_reg += ps;
#define PK4(P, BASE, OUT) do { unsigned a0 = cvtpk(P[BASE + 0], P[BASE + 1]), a1 = cvtpk(P[BASE + 2], P[BASE + 3]);   \
    unsigned b0 = cvtpk(P[BASE + 4], P[BASE + 5]), b1 = cvtpk(P[BASE + 6], P[BASE + 7]);                              \
    auto r0 = __builtin_amdgcn_permlane32_swap(a0, b0, false, false); auto r1 = __builtin_amdgcn_permlane32_swap(a1, b1, false, false); \
    u32x4 w = {r0[0], r1[0], r0[1], r1[1]}; OUT = __builtin_bit_cast(bf16x8, w); } while (0)
    PK4(p0, 0, pa0); PK4(p0, 8, pa1); PK4(p1, 0, pa2); PK4(p1, 8, pa3);
#undef PK4
}
DI void qkt(f32x16& p0, f32x16& p1, const LAS unsigned char* Ks, const bf16x8* qr, int r32, int hi) {
#pragma unroll
    for (int r = 0; r < 16; ++r) { p0[r] = 0.f; p1[r] = 0.f; }
#pragma unroll
    for (int d0 = 0; d0 < 6; ++d0) { const int cb = (d0 * 16 + hi * 8) * 2;
        const bf16x8 b0 = *(const LAS bf16x8*)(Ks + KSWZ(r32, cb));
        const bf16x8 b1 = *(const LAS bf16x8*)(Ks + KSWZ(32 + r32, cb));
        p0 = __builtin_amdgcn_mfma_f32_32x32x16_bf16(b0, qr[d0], p0, 0, 0, 0);
        p1 = __builtin_amdgcn_mfma_f32_32x32x16_bf16(b1, qr[d0], p1, 0, 0, 0); }
}
DI int v_st(int k, int c) { const int kk = (k & ~0xC) | ((k & 4) << 1) | ((k & 8) >> 1); return ((kk >> 3) * 2 + (c >> 5)) * 512 + ((kk & 7) * 32 + (c & 31)) * 2; }
DI int v_rd_base(int lane) { return ((lane & 3) << 3) | (((lane >> 2) & 3) << 6) | (((lane >> 4) & 1) << 5) | (((lane >> 5) & 1) << 8); }
constexpr int v_rd_off(int d0, int ks, int half) { return d0 * 512 + ks * 2048 + half * 1024; }
template <int OFF> DI s16x4 tr_read(int vb) { s16x4 r; asm volatile("ds_read_b64_tr_b16 %0, %1 offset:%2" : "=&v"(r) : "v"(vb), "i"(OFF) : "memory"); return r; }
template <int D0> DI void pv_one(f32x16& od, int vb, bf16x8 pa0, bf16x8 pa1, bf16x8 pa2, bf16x8 pa3) {
    const s16x4 l0 = tr_read<v_rd_off(D0, 0, 0)>(vb), h0 = tr_read<v_rd_off(D0, 0, 1)>(vb), l1 = tr_read<v_rd_off(D0, 1, 0)>(vb), h1 = tr_read<v_rd_off(D0, 1, 1)>(vb);
    const s16x4 l2 = tr_read<v_rd_off(D0, 2, 0)>(vb), h2 = tr_read<v_rd_off(D0, 2, 1)>(vb), l3 = tr_read<v_rd_off(D0, 3, 0)>(vb), h3 = tr_read<v_rd_off(D0, 3, 1)>(vb);
    asm volatile("s_waitcnt lgkmcnt(0)" ::: "memory"); SBAR();
#define PKV(L, H) (bf16x8){L[0], L[1], L[2], L[3], H[0], H[1], H[2], H[3]}
    od = __builtin_amdgcn_mfma_f32_32x32x16_bf16(pa0, PKV(l0, h0), od, 0, 0, 0);
    od = __builtin_amdgcn_mfma_f32_32x32x16_bf16(pa1, PKV(l1, h1), od, 0, 0, 0);
    od = __builtin_amdgcn_mfma_f32_32x32x16_bf16(pa2, PKV(l2, h2), od, 0, 0, 0);
    od = __builtin_amdgcn_mfma_f32_32x32x16_bf16(pa3, PKV(l3, h3), od, 0, 0, 0);
#undef PKV
}
DI void pv_d0(f32x16* o, int vb, bf16x8 pa0, bf16x8 pa1, bf16x8 pa2, bf16x8 pa3) {
    pv_one<0>(o[0], vb, pa0, pa1, pa2, pa3); pv_one<1>(o[1], vb, pa0, pa1, pa2, pa3);
}
DI void attn_unit(const Frame& F, const bf16_t* __restrict__ Qb, const bf16_t* __restrict__ Kh, const bf16_t* __restrict__ Vh, bf16_t* __restrict__ Ob, int seq, float kmax2) {
    const int tid = F.tid, wid = F.wid, lane = F.lane, r32 = lane & 31, hi = lane >> 5;
    LAS unsigned char* V_lds = F.lds; LAS unsigned char* K_lds = F.lds + 3 * AT_SHM_V;
    LAS float* li_l = (LAS float*)(F.lds + 3 * AT_SHM_V + 3 * AT_SHM_K) + wid * 32;
    float l_reg = 0;
    f32x16 o[2];
#pragma unroll
    for (int r = 0; r < 16; ++r) { o[0][r] = 0.f; o[1][r] = 0.f; }
    bf16x8 qr[6];
    const bf16_t* Qw = Qb + (size_t)(wid * 32 + r32) * 96 + hi * 8;
    float qn2 = 0.f;
#pragma unroll
    for (int d0 = 0; d0 < 6; ++d0) { qr[d0] = *(const bf16x8*)(Qw + d0 * 16);
#pragma unroll
        for (int j = 0; j < 8; ++j) { const float qv = bf2f((unsigned)(unsigned short)qr[d0][j]); qn2 = fmaf(qv, qv, qn2); } }
    qn2 += __shfl_xor(qn2, 32);
    constexpr float C = AT_SCALE * 1.4426950408889634f;
    const float mnC = -(sqrtf(qn2 * kmax2) * 1.02f + 1e-3f) * C;
    const int sr = tid >> 4, sc = (tid & 15) * 8;
    const int vk = tid >> 3, vc = (tid & 7) * 8;
    const int vst = v_st(vk, vc);
    const int vb0 = (int)(uintptr_t)V_lds + v_rd_base(lane);
    struct { bf16x8 vs0, ks0, ks1; } sr_;
    const unsigned kofs0 = (unsigned)(sr * 128 + sc) * 2u, kofs1 = kofs0 + 32u * 256u, vofs = (unsigned)(vk * 64 + vc) * 2u;
#define SLOAD(k0) do { const char* Vt_ = (const char*)Vh + (size_t)(k0) * 128; const char* Kt_ = (const char*)Kh + (size_t)(k0) * 256; \
    sr_.vs0 = *(const bf16x8*)(Vt_ + vofs); sr_.ks0 = *(const bf16x8*)(Kt_ + kofs0); sr_.ks1 = *(const bf16x8*)(Kt_ + kofs1); } while (0)
#define SWRITE(b) do { asm volatile("s_waitcnt vmcnt(0)" ::: "memory"); *(LAS bf16x8*)(V_lds + (b) * AT_SHM_V + vst) = sr_.vs0; const int kc = sc * 2; \
    *(LAS bf16x8*)(K_lds + (b) * AT_SHM_K + KSWZ(sr, kc)) = sr_.ks0; *(LAS bf16x8*)(K_lds + (b) * AT_SHM_K + KSWZ(32 + sr, kc)) = sr_.ks1; } while (0)
#define ROT() do { const int t_ = bp; bp = bc; bc = bn; bn = t_; } while (0)
    f32x16 pA0, pA1, pB0, pB1; bf16x8 pa0, pa1, pa2, pa3; const int NT = seq / 64;
    __syncthreads();
    SLOAD(0); SWRITE(0); SLOAD(64);
    __syncthreads();
    qkt(pA0, pA1, K_lds, qr, r32, hi); partialSM(pA0, pA1, mnC);
    SWRITE(1); __syncthreads();
    int bc = 1, bp = 0, bn = 2;
    for (int j = 1; j + 1 < NT; j += 2) {
        SLOAD((j + 1) * 64); SBAR();
        qkt(pB0, pB1, K_lds + bc * AT_SHM_K, qr, r32, hi);
        finishSM(pA0, pA1, l_reg, pa0, pa1, pa2, pa3); SBAR();
        pv_d0(o, vb0 + bp * AT_SHM_V, pa0, pa1, pa2, pa3); partialSM(pB0, pB1, mnC);
        SWRITE(bn);
        __syncthreads(); ROT();
        SLOAD((j + 2) * 64); SBAR();
        qkt(pA0, pA1, K_lds + bc * AT_SHM_K, qr, r32, hi);
        finishSM(pB0, pB1, l_reg, pa0, pa1, pa2, pa3); SBAR();
        pv_d0(o, vb0 + bp * AT_SHM_V, pa0, pa1, pa2, pa3); partialSM(pA0, pA1, mnC);
        SWRITE(bn);
        __syncthreads(); ROT();
    }
    SBAR(); qkt(pB0, pB1, K_lds + bc * AT_SHM_K, qr, r32, hi);
    finishSM(pA0, pA1, l_reg, pa0, pa1, pa2, pa3); SBAR();
    pv_d0(o, vb0 + bp * AT_SHM_V, pa0, pa1, pa2, pa3); partialSM(pB0, pB1, mnC);
    finishSM(pB0, pB1, l_reg, pa0, pa1, pa2, pa3); SBAR();
    pv_d0(o, vb0 + bc * AT_SHM_V, pa0, pa1, pa2, pa3);
    l_reg += __shfl_xor(l_reg, 32);
    if (hi == 0) li_l[r32] = l_reg; asm volatile("s_waitcnt lgkmcnt(0)" ::: "memory");
    float rli[16];
#pragma unroll
    for (int r = 0; r < 16; ++r) rli[r] = __builtin_amdgcn_rcpf(li_l[crow(r, hi)]);
    bf16_t* Ow = Ob + (size_t)(wid * 32) * 1024;
#pragma unroll
    for (int r = 0; r < 16; ++r) { const int orow = crow(r, hi);
#pragma unroll
        for (int d0 = 0; d0 < 2; ++d0) Ow[(size_t)orow * 1024 + d0 * 32 + r32] = (bf16_t)f2bf(o[d0][r] * rli[r]); }
#undef SLOAD
#undef SWRITE
#undef ROT
}

constexpr int HF_LD = 264;
DI void hgrn_fix_unit(const Frame& F, int l, int u) {
    const int tid = F.tid, lane = F.lane, wid = F.wid, fr = lane & 15, fq = lane >> 4;
    int b, hh, seg, half;
    if (u < 256) { b = u >> 7; hh = (u >> 5) & 3; seg = 1 + ((u >> 1) & 15); half = u & 1; } else { b = (u - 256) >> 2; hh = (u - 256) & 3; seg = 0; half = 0; }
    LAS bf16_t* SIB = (LAS bf16_t*)F.lds;
    __syncthreads();
    if (seg != 0) {
        for (int dir = 0; dir < 2; ++dir) {
            const int chain = b * 8 + hh * 2 + dir;
            const int sseg = dir == 0 ? seg : NSEG - seg;
            const float* SL = WSP(const float, WS_SLOC) + (size_t)chain * NSEG * 8192;
            const float* DT = WSP(const float, WS_DTOT) + (size_t)chain * NSEG * 128;
            float a[16];
#pragma unroll
            for (int i = 0; i < 16; ++i) a[i] = 0.f;
#pragma unroll 2
            for (int j = 0; j < sseg; ++j) {
                float sv[16], dv[16];
#pragma unroll
                for (int i = 0; i < 16; ++i) { sv[i] = SL[(size_t)j * 8192 + tid + i * 512]; dv[i] = DT[j * 128 + (tid >> 6) + i * 8]; }
#pragma unroll
                for (int i = 0; i < 16; ++i) a[i] = fmaf(__expf(dv[i]), a[i], sv[i]);
            }
#pragma unroll
            for (int i = 0; i < 16; ++i) { const int idx = tid + i * 512, d = idx >> 6, e = idx & 63; SIB[e * HF_LD + dir * 128 + d] = (bf16_t)f2bf(a[i]); }
        }
    }
    __syncthreads();
    const int len = 256, t0 = seg == 0 ? 0 : (seg - 1) * 512 + half * 256;
    const size_t rowbase = seg == 0 ? (size_t)NLAT + b * CTX : (size_t)b * SEQ;
    const float* OL0 = WSP(const float, WS_OLOC); const float* OL1 = OL0 + (size_t)NTOK * 256;
    const bf16_t* QC0 = WSP(const bf16_t, WS_QCUM);
    for (int tile = wid; tile < (len >> 4); tile += 8) {
        const size_t row = rowbase + t0 + tile * 16 + fr;
        f32x4 acc[4];
#pragma unroll
        for (int et = 0; et < 4; ++et) acc[et] = (f32x4){0.f, 0.f, 0.f, 0.f};
        if (seg != 0) {
#pragma unroll
            for (int ks = 0; ks < 8; ++ks) {
                const bf16x8 qf = *(const bf16x8*)(QC0 + (size_t)(ks >> 2) * NTOK * 512 + row * 512 + hh * 128 + (ks & 3) * 32 + fq * 8);
#pragma unroll
                for (int et = 0; et < 4; ++et) {
                    const bf16x8 sf = *(const LAS bf16x8*)(SIB + (et * 16 + fr) * HF_LD + ks * 32 + fq * 8);
                    acc[et] = __builtin_amdgcn_mfma_f32_16x16x32_bf16(sf, qf, acc[et], 0, 0, 0);
                }
            }
        }
        float ss = 0.f;
#pragma unroll
        for (int et = 0; et < 4; ++et) {
            const f32x4 o0 = *(const f32x4*)(OL0 + row * 256 + hh * 64 + et * 16 + fq * 4), o1 = *(const f32x4*)(OL1 + row * 256 + hh * 64 + et * 16 + fq * 4);
            acc[et] = acc[et] + o0 + o1;
#pragma unroll
            for (int r = 0; r < 4; ++r) ss = fmaf(acc[et][r], acc[et][r], ss);
        }
        ss += __shfl_xor(ss, 16); ss += __shfl_xor(ss, 32);
        const float rs = rsqrtf(ss * (1.f / 64.f) + EPS);
#pragma unroll
        for (int et = 0; et < 4; ++et) {
            const int e0 = hh * 64 + et * 16 + fq * 4;
            const f32x4 ng = *(const f32x4*)(inp(F, I_HGNG) + l * 256 + e0);
            const u32x2 gt = *(const u32x2*)(WSP(const bf16_t, WS_GATE) + row * 256 + e0);
            const float g0 = bf2f(gt[0] & 0xffffu), g1 = bf2f(gt[0] >> 16), g2 = bf2f(gt[1] & 0xffffu), g3 = bf2f(gt[1] >> 16);
            *(u32x2*)(WSP(bf16_t, WS_MIX) + row * 1024 + 256 + e0) = (u32x2){cvtpk(acc[et][0] * rs * ng[0] * g0, acc[et][1] * rs * ng[1] * g1), cvtpk(acc[et][2] * rs * ng[2] * g2, acc[et][3] * rs * ng[3] * g3)};
        }
    }
}

DI void phase_attn(const Frame& Fin, int l) {
    PHASE_FRAME(Fin);
    {
        const int xcd = F.bid & 7, j = F.bid >> 3;
        for (int i = 0; i < 2; ++i) {
            const int bh = xcd * 2 + i, qb = j, b = bh >> 3, hd = bh & 7;
            const size_t kv0 = (size_t)bh * NKEY;
            const unsigned* kmw = WSP(const unsigned, WS_CTL) + CW_KMAX + (l * 16 + bh) * 2;
            attn_unit(F, WSP(const bf16_t, WS_QB) + (kv0 + qb * 256) * 96, WSP(const bf16_t, WS_KB) + kv0 * 128, WSP(const bf16_t, WS_VB) + kv0 * 64,
                      WSP(bf16_t, WS_MIX) + ((size_t)b * SEQ + qb * 256) * 1024 + 512 + hd * 64, NKEY, __uint_as_float(kmw[0]) + __uint_as_float(kmw[1]));
        }
        if (F.bid >= 240) {
            const int bh = F.bid - 240, b = bh >> 3, hd = bh & 7;
            const size_t kv0 = (size_t)bh * NKEY + SEQ;
            const unsigned* kmw = WSP(const unsigned, WS_CTL) + CW_KMAX + (l * 16 + bh) * 2;
            attn_unit(F, WSP(const bf16_t, WS_QB) + kv0 * 96, WSP(const bf16_t, WS_KB) + kv0 * 128, WSP(const bf16_t, WS_VB) + kv0 * 64,
                      WSP(bf16_t, WS_MIX) + ((size_t)NLAT + b * CTX) * 1024 + 512 + hd * 64, CTX, __uint_as_float(kmw[0]) + __uint_as_float(kmw[1]));
        }
    }
    __syncthreads();
    { PHASE_FRAME2(F); for (int u = F2.bid; u < 264; u += F2.G) hgrn_fix_unit(F2, l, u); }
}

struct EpiWout {
    Frame F;
    DI void operator()(const f32x4 (&acc)[2][2][4][2], const g8::Unit& u, int wr, int wc, int fr, int fq) const {
#pragma unroll
        for (int bj = 0; bj < 2; ++bj) { FOR_AMN { *(f32x4*)(WSP(float, WS_M) + ROW_ * 1024 + u.pn * 256 + bj * 128 + wc * 32 + n * 16 + fq * 4) = acc[ai][bj][m][n]; } }
    }
};
DI void phase_wout(const Frame& Fin) {
    PHASE_FRAME(Fin);
    g8::DenseSched S; S.init(NTOK, 1024, 1024, F.G, F.bid, WSP(const bf16_t, WS_MIX), WSP(const bf16_t, WS_WOUT));
    EpiWout E; E.F = F;
    g8::gemm8<false>(F, 1024, S, E);
}

DI void phase_ln1_router(const Frame& Fin, int l, int rep = 0) {
    PHASE_FRAME(Fin);
    const int tid = F.tid, lane = F.lane;
    LAS float* RW = (LAS float*)F.lds;
    __syncthreads();
    {
        f32x4 ew[16], gw[2];
        const float* REW = inp(F, I_REW) + (size_t)l * 32768; const float* RGW = inp(F, I_RGW) + (size_t)l * 4096;
#pragma unroll
        for (int n = 0; n < 16; ++n) ew[n] = *(const f32x4*)(REW + (size_t)(tid + n * 512) * 4);
#pragma unroll
        for (int n = 0; n < 2; ++n) gw[n] = *(const f32x4*)(RGW + (size_t)(tid + n * 512) * 4);
#pragma unroll
        for (int n = 0; n < 16; ++n) { const int q = tid + n * 512, k = q >> 3, c4 = (q & 7) * 4;
#pragma unroll
            for (int j = 0; j < 4; ++j) RW[(4 + c4 + j) * 1024 + k] = ew[n][j]; }
#pragma unroll
        for (int n = 0; n < 2; ++n) { const int k = tid + n * 512;
#pragma unroll
            for (int j = 0; j < 4; ++j) RW[j * 1024 + k] = gw[n][j]; }
    }
    __syncthreads();
    unsigned* cnt = WSP(unsigned, WS_CTL) + CW_CNT + l * 32;
    float a1[16], b1[16];
    row_load(inp(F, I_LN1G) + l * 1024, lane, a1); row_load(inp(F, I_LN1B) + l * 1024, lane, b1);
    for (int grp = F.bid * 8 + F.wid; grp < NTOK / 3; grp += F.G * 8) {
        float v[3][16];
#pragma unroll
        for (int r = 0; r < 3; ++r) {
            const int row = grp * 3 + r;
            const float* md = WSP(const float, WS_MOD) + (size_t)(l * 3 + row_seq(row)) * 6144;
            float t[16], g1[16];
            row_load(x_in_row(F, l, row), lane, v[r]);
            row_load(WSP(const float, WS_M) + (size_t)row * DM, lane, t);
            row_load(md + 2048, lane, g1);
#pragma unroll
            for (int i = 0; i < 16; ++i) v[r][i] = fmaf(ALPHA, v[r][i], g1[i] * t[i]);
        }
#pragma unroll
        for (int r = 0; r < 3; ++r) {
            const int row = grp * 3 + r;
            const float* md = WSP(const float, WS_MOD) + (size_t)(l * 3 + row_seq(row)) * 6144;
            row_ln(v[r]);
#pragma unroll
            for (int i = 0; i < 16; ++i) v[r][i] = fmaf(v[r][i], a1[i], b1[i]);
            row_store(WSP(float, WS_X1) + (size_t)row * DM, lane, v[r]);
            row_ln(v[r]);
            float sh[16], sc[16]; row_load(md + 3072, lane, sh); row_load(md + 4096, lane, sc);
#pragma unroll
            for (int i = 0; i < 16; ++i) v[r][i] = fmaf(v[r][i], 1.f + sc[i], sh[i]);
            row_store_bf16(WSP(bf16_t, WS_H) + (size_t)row * DM, lane, v[r]);
        }
        float mylg[3] = {0.f, 0.f, 0.f};
#pragma unroll 4
        for (int c = 0; c < 36; ++c) {
            f32x4 w[4];
#pragma unroll
            for (int i = 0; i < 4; ++i) w[i] = *(const LAS f32x4*)(RW + c * 1024 + lane * 4 + i * 256);
#pragma unroll
            for (int r = 0; r < 3; ++r) {
                float sacc = 0.f;
#pragma unroll
                for (int i = 0; i < 4; ++i) { sacc = fmaf(v[r][4 * i], w[i][0], sacc); sacc = fmaf(v[r][4 * i + 1], w[i][1], sacc); sacc = fmaf(v[r][4 * i + 2], w[i][2], sacc); sacc = fmaf(v[r][4 * i + 3], w[i][3], sacc); }
                sacc = wave_sum(sacc);
                mylg[r] = (lane == c) ? sacc : mylg[r];
            }
        }
        if (rep == 0) {
#pragma unroll
            for (int r = 0; r < 3; ++r) {
                const int row = grp * 3 + r;
                float g[4]; int gs = 0;
#pragma unroll
                for (int c = 0; c < 4; ++c) g[c] = __uint_as_float(__builtin_amdgcn_readlane(__float_as_uint(mylg[r]), c)) + inp(F, I_RGB)[l * 4 + c];
                float gm = g[0];
#pragma unroll
                for (int c = 1; c < 4; ++c) if (g[c] > gm) { gm = g[c]; gs = c; }
                float se = 0.f;
#pragma unroll
                for (int c = 0; c < 4; ++c) se += expf(g[c] - gm);
                const float wg = 1.f / se;
                float e[8];
#pragma unroll
                for (int c = 0; c < 8; ++c) e[c] = __uint_as_float(__builtin_amdgcn_readlane(__float_as_uint(mylg[r]), 4 + gs * 8 + c)) + inp(F, I_REB)[l * 32 + gs * 8 + c];
                int i0 = 0; float v0 = e[0];
#pragma unroll
                for (int c = 1; c < 8; ++c) if (e[c] > v0) { v0 = e[c]; i0 = c; }
                int i1 = -1; float v1 = -3.0e38f;
#pragma unroll
                for (int c = 0; c < 8; ++c) if (c != i0 && e[c] > v1) { v1 = e[c]; i1 = c; }
                const float p1 = expf(v1 - v0), den = 1.f / (1.f + p1);
                const float w0 = den * wg, w1 = p1 * den * wg;
                const int e0 = gs * 8 + i0, e1 = gs * 8 + i1;
                if (lane == 0) {
                    const unsigned pos0 = atomicAdd(&cnt[e0], 1u), pos1 = atomicAdd(&cnt[e1], 1u);
                    WSP(int, WS_LIST)[(size_t)e0 * NTOK + pos0] = row; WSP(float, WS_LISTW)[(size_t)e0 * NTOK + pos0] = w0;
                    WSP(int, WS_LIST)[(size_t)e1 * NTOK + pos1] = row; WSP(float, WS_LISTW)[(size_t)e1 * NTOK + pos1] = w1;
                    int* ts = WSP(int, WS_TOKSLOT) + (size_t)row * 4; ts[0] = e0; ts[1] = (int)pos0; ts[2] = e1; ts[3] = (int)pos1;
                }
            }
        }
    }
}

DI void moe_bases(const Frame& F, int l, LAS int* base  , LAS int* cnts  ) {
    __syncthreads();
    if (F.tid == 0) {
        const unsigned* cnt = WSP(const unsigned, WS_CTL) + CW_CNT + l * 32;
        int a = 0;
        for (int e = 0; e < 32; ++e) { const int c = (int)cnt[e]; cnts[e] = c; base[e] = a; a += (c + 255) / 256 * 256; }
        base[32] = a;
    }
    __syncthreads();
}

struct MoeSched {
    LAS const int* base; LAS const int* cnts; int ntile, nN, G, c; const char* A; const char* B; size_t estepB, tstepB, tstepA; const int* list; bool gather;
    DI bool next(int i, g8::Unit& u) const {
        const long L = (long)i * G + c; if (L >= (long)ntile * nN) return false;
        const int rt = (int)(L / nN), ct = (int)(L % nN), slot0 = rt * 256;
        int e = 0;
        for (int q = 1; q < 32; ++q) if (slot0 >= base[q]) e = q;
        const int pos0 = slot0 - base[e];
        u.pm = rt; u.pn = ct; u.B = B + (size_t)e * estepB + (size_t)ct * tstepB;
        if (gather) { u.A = A; u.rowidx = list + (size_t)e * NTOK + pos0; u.nvalid = cnts[e] - pos0; }
        else { u.A = A + (size_t)rt * tstepA; u.rowidx = nullptr; u.nvalid = e * 65536 + 0; }
        return true;
    }
};
struct EpiMoeUp {
    Frame F;
    DI void operator()(const f32x4 (&acc)[2][2][4][2], const g8::Unit& u, int wr, int wc, int fr, int fq) const {
        bf16_t* ACT = WSP(bf16_t, WS_ACT);
#pragma unroll
        for (int bj = 0; bj < 2; ++bj) {
            const int hc = 16 * ((u.pn * 256 + bj * 128 + wc * 32) / 32) + fq * 4;
#pragma unroll
            for (int ai = 0; ai < 2; ++ai)
#pragma unroll
                for (int m = 0; m < 4; ++m) {
                    const f32x4 a = acc[ai][bj][m][0], bq = acc[ai][bj][m][1];
                    *(u32x2*)(ACT + ROW_ * 512 + hc) = (u32x2){cvtpk(silu_f(a[0]) * bq[0], silu_f(a[1]) * bq[1]), cvtpk(silu_f(a[2]) * bq[2], silu_f(a[3]) * bq[3])};
                }
        }
    }
};
DI void phase_moe_up(const Frame& Fin, int l) {
    PHASE_FRAME(Fin);
    LAS int* base = (LAS int*)(F.lds + LDS_MAIN + 64); LAS int* cnts = base + 40;
    moe_bases(F, l, base, cnts);
    MoeSched S; S.base = base; S.cnts = cnts; S.ntile = base[32] / 256; S.nN = 4; S.G = F.G; S.c = F.bid; S.A = (const char*)WSP(const bf16_t, WS_H); S.B = (const char*)WSP(const bf16_t, WS_W13);
    S.estepB = (size_t)1024 * 1024 * 2; S.tstepB = (size_t)256 * 1024 * 2; S.tstepA = 0; S.list = WSP(const int, WS_LIST); S.gather = true;
    EpiMoeUp E; E.F = F;
    g8::gemm8<true>(F, 1024, S, E);
}
struct EpiMoeDown {
    Frame F; LAS const int* base; LAS const int* cnts;
    DI void operator()(const f32x4 (&acc)[2][2][4][2], const g8::Unit& u, int wr, int wc, int fr, int fq) const {
        bf16_t* Y = WSP(bf16_t, WS_Y);
        const int e = u.nvalid >> 16, pos0 = u.pm * 256 - base[e], ce = cnts[e];
#pragma unroll
        for (int ai = 0; ai < 2; ++ai)
#pragma unroll
            for (int m = 0; m < 4; ++m) {
                const int pos = pos0 + ai * 128 + wr * 64 + m * 16 + fr;
                const float w = pos < ce ? WSP(const float, WS_LISTW)[(size_t)e * NTOK + pos] : 0.f;
#pragma unroll
                for (int bj = 0; bj < 2; ++bj)
#pragma unroll
                    for (int n = 0; n < 2; ++n) { const f32x4 v = acc[ai][bj][m][n] * w;
                        *(u32x2*)(Y + ROW_ * 1024 + u.pn * 256 + bj * 128 + wc * 32 + n * 16 + fq * 4) = PKV2(v); }
            }
    }
};
DI void phase_moe_down(const Frame& Fin, int l) {
    PHASE_FRAME(Fin);
    LAS int* base = (LAS int*)(F.lds + LDS_MAIN + 64); LAS int* cnts = base + 40;
    moe_bases(F, l, base, cnts);
    MoeSched S; S.base = base; S.cnts = cnts; S.ntile = base[32] / 256; S.nN = 4; S.G = F.G; S.c = F.bid; S.A = (const char*)WSP(const bf16_t, WS_ACT); S.B = (const char*)WSP(const bf16_t, WS_W2);
    S.estepB = (size_t)1024 * 512 * 2; S.tstepB = (size_t)256 * 512 * 2; S.tstepA = (size_t)256 * 512 * 2; S.list = nullptr; S.gather = false;
    EpiMoeDown E; E.F = F; E.base = base; E.cnts = cnts;
    g8::gemm8<false>(F, 512, S, E);
}

DI void row_load_bf16(const bf16_t* p, int lane, float (&v)[16]) {
#pragma unroll
    for (int i = 0; i < 4; ++i) { const u32x2 t = *(const u32x2*)(p + lane * 4 + i * 256); v[4 * i] = bf2f(t[0] & 0xffffu); v[4 * i + 1] = bf2f(t[0] >> 16); v[4 * i + 2] = bf2f(t[1] & 0xffffu); v[4 * i + 3] = bf2f(t[1] >> 16); }
}
DI void phase_ln2(const Frame& Fin, int l) {
    PHASE_FRAME(Fin);
    const int lane = F.lane;
    LAS int* base = (LAS int*)(F.lds + LDS_MAIN + 64); LAS int* cnts = base + 40;
    moe_bases(F, l, base, cnts);
    float a2[16], b2[16];
    row_load(inp(F, I_LN2G) + l * 1024, lane, a2); row_load(inp(F, I_LN2B) + l * 1024, lane, b2);
    const int nrow = (l == 3) ? NLAT : NTOK;
    for (int grp = F.bid * 8 + F.wid; grp * 3 < nrow; grp += F.G * 8) {
        float v[3][16];
#pragma unroll
        for (int r = 0; r < 3; ++r) {
            const int row = min(grp * 3 + r, nrow - 1);
            const float* md = WSP(const float, WS_MOD) + (size_t)(l * 3 + row_seq(row)) * 6144;
            const int* ts = WSP(const int, WS_TOKSLOT) + (size_t)row * 4;
            const size_t s0 = (size_t)base[ts[0]] + ts[1], s1 = (size_t)base[ts[2]] + ts[3];
            float y0[16], y1[16], g2[16];
            row_load(WSP(const float, WS_X1) + (size_t)row * DM, lane, v[r]);
            row_load_bf16(WSP(const bf16_t, WS_Y) + s0 * 1024, lane, y0);
            row_load_bf16(WSP(const bf16_t, WS_Y) + s1 * 1024, lane, y1);
            row_load(md + 5120, lane, g2);
#pragma unroll
            for (int i = 0; i < 16; ++i) v[r][i] = fmaf(ALPHA, v[r][i], g2[i] * (y0[i] + y1[i]));
        }
#pragma unroll
        for (int r = 0; r < 3; ++r) {
            const int row = grp * 3 + r;
            row_ln(v[r]);
#pragma unroll
            for (int i = 0; i < 16; ++i) v[r][i] = fmaf(v[r][i], a2[i], b2[i]);
            if (row < nrow) {
                if (l == 3) row_store((float*)(F.out + (size_t)row * DM), lane, v[r]);
                else row_store(WSP(float, WS_X) + (size_t)row * DM, lane, v[r]);
            }
        }
        if (l < 3) {
#pragma unroll
            for (int r = 0; r < 3; ++r) {
                const int row = grp * 3 + r;
                row_ln(v[r]);
                const float* md2 = WSP(const float, WS_MOD) + (size_t)((l + 1) * 3 + row_seq(min(row, nrow - 1))) * 6144;
                float sh[16], sc[16]; row_load(md2, lane, sh); row_load(md2 + 1024, lane, sc);
#pragma unroll
                for (int i = 0; i < 16; ++i) v[r][i] = fmaf(v[r][i], 1.f + sc[i], sh[i]);
                if (row < nrow) row_store_bf16(WSP(bf16_t, WS_H) + (size_t)row * DM, lane, v[r]);
            }
        }
    }
    if (l < 3) { __syncthreads(); phase_convert(F, l + 1); }
}

constexpr int N_STEPS = 2 + 4 * 8;
__global__ void __launch_bounds__(512, 2) mega(Params P) {
    extern __shared__ __attribute__((aligned(16))) unsigned char lds_raw[];
    Frame F;
    F.in = (kin_t)__builtin_amdgcn_kernarg_segment_ptr();
    F.out = (GAS float*)P.out; F.ws = (GAS unsigned char*)P.ws; F.lds = (LAS unsigned char*)lds_raw;
    F.tid = threadIdx.x; F.lane = F.tid & 63; F.wid = __builtin_amdgcn_readfirstlane(F.tid >> 6); F.G = gridDim.x; F.bid = blockIdx.x;
    const int s_lo = P.s_lo, s_hi = P.s_hi;
    if (F.tid < 64) ((LAS unsigned*)(F.lds + LDS_MAIN))[F.tid] = 0u;
    __syncthreads();
    XcdBarrier bar; bar.bar = WSP(unsigned, WS_CTL) + CW_BAR; bar.x = 0; bar.st = (volatile LAS unsigned*)(F.lds + LDS_MAIN);
    if (s_hi - s_lo > 1) bar = xcd_barrier_post(WSP(unsigned, WS_CTL) + CW_BAR, (volatile LAS unsigned*)(F.lds + LDS_MAIN));
#if defined(EXCL_PH)
#define PH_ON(k) ((k) != EXCL_PH)
#elif !defined(ONLY_PH)
#define PH_ON(k) true
#else
#define PH_ON(k) ((k) == ONLY_PH)
#endif
#ifndef DUP_PH
#define DUP_PH -1
#endif
#define REPS(k) int reps_ = 1 + ((k) == DUP_PH ? 1 : 0); asm volatile("" : "+s"(reps_)); _Pragma("unroll 1") for (int rep_ = 0; rep_ < reps_; ++rep_)
#define STEP(s) (s_lo <= (s) && (s) < s_hi)
#define SEAM(s) do { if (STEP(s) && STEP((s) + 1)) xcd_barrier(bar); } while (0)
    if (STEP(0) && PH_ON(0)) { REPS(0) phase_setup(F); }
    SEAM(0);
    if (STEP(1) && PH_ON(1)) { REPS(1) phase_mod0(F); }
    SEAM(1);
#pragma unroll 1
    for (int l = 0; l < 4; ++l) {
        const int sb = 2 + l * 8;
        if (STEP(sb + 0) && PH_ON(2)) { REPS(2) phase_proj(F, l); }
        SEAM(sb + 0);
        if (STEP(sb + 1) && PH_ON(3)) { REPS(3) phase_local(F, l); }
        SEAM(sb + 1);
        if (STEP(sb + 2) && PH_ON(4)) { REPS(4) phase_attn(F, l); }
        SEAM(sb + 2);
        if (STEP(sb + 3) && PH_ON(5)) { REPS(5) phase_wout(F); }
        SEAM(sb + 3);
        if (STEP(sb + 4) && PH_ON(6)) { REPS(6) phase_ln1_router(F, l, rep_); }
        SEAM(sb + 4);
        if (STEP(sb + 5) && PH_ON(7)) { REPS(7) phase_moe_up(F, l); }
        SEAM(sb + 5);
        if (STEP(sb + 6) && PH_ON(8)) { REPS(8) phase_moe_down(F, l); }
        SEAM(sb + 6);
        if (STEP(sb + 7) && PH_ON(9)) { REPS(9) phase_ln2(F, l); }
        SEAM(sb + 7);
    }
}

extern "C" void kernel_launch(void* const* d_in, const int* in_sizes, int n_in, void* d_out, int out_size, void* d_ws, size_t ws_size, hipStream_t stream) {
    static int grid = 0;
    if (grid == 0) {
        if (n_in != 27 || out_size != NLAT * DM || ws_size < WS_END) {
            fprintf(stderr, "kernel_launch: shape mismatch: n_in %d out %d ws %zu (need %zu)\n", n_in, out_size, ws_size, (size_t)WS_END); grid = -1; return; }
        int dev = 0, cus = 0, per_cu = 0;
        if (hipGetDevice(&dev) != hipSuccess || hipDeviceGetAttribute(&cus, hipDeviceAttributeMultiprocessorCount, dev) != hipSuccess) { grid = -1; return; }
        if (hipFuncSetAttribute((const void*)mega, hipFuncAttributeMaxDynamicSharedMemorySize, LDS_BYTES) != hipSuccess) { fprintf(stderr, "kernel_launch: hipFuncSetAttribute failed\n"); grid = -1; return; }
        if (hipOccupancyMaxActiveBlocksPerMultiprocessor(&per_cu, (const void*)mega, 512, LDS_BYTES) != hipSuccess || per_cu < 1) fprintf(stderr, "kernel_launch: occupancy query says %d\n", per_cu);
        (void)hipGetLastError();
        if (cus != 256) { fprintf(stderr, "kernel_launch: built for 256 CUs, found %d\n", cus); grid = -1; return; }
        grid = cus;
    }
    if (grid < 0) return;
    if (hipMemsetAsync((char*)d_ws + WS_CTL, 0, CTL_BYTES, stream) != hipSuccess) return;
    Params p{};
    for (int i = 0; i < 27; ++i) p.in[i] = (const float*)d_in[i];
    p.out = (float*)d_out; p.ws = (unsigned char*)d_ws;
#if MK_MULTI
    for (int s = 0; s < N_STEPS; ++s) { p.s_lo = s; p.s_hi = s + 1; hipLaunchKernelGGL(mega, dim3(grid), dim3(512), LDS_BYTES, stream, p); }
#else
    p.s_lo = 0; p.s_hi = N_STEPS;
    hipLaunchKernelGGL(mega, dim3(grid), dim3(512), LDS_BYTES, stream, p);
#endif
    const hipError_t le = hipPeekAtLastError();
    if (le != hipSuccess) fprintf(stderr, "kernel_launch: launch failed: %s\n", hipGetErrorName(le));
}
```

```cpp
#include <hip/hip_runtime.h>
#include <cstdio>
#include <cstdint>

#ifndef MK_MULTI
#define MK_MULTI 0
#endif

typedef unsigned short bf16_t;
typedef short bf16x8 __attribute__((ext_vector_type(8)));
typedef short s16x4 __attribute__((ext_vector_type(4)));
typedef float f32x4 __attribute__((ext_vector_type(4)));
typedef float f32x16 __attribute__((ext_vector_type(16)));
typedef unsigned u32x4 __attribute__((ext_vector_type(4)));
typedef unsigned u32x2 __attribute__((ext_vector_type(2)));
#define LAS __attribute__((address_space(3)))
#define DI __device__ __forceinline__

DI unsigned f2bf(float f) { unsigned u = __float_as_uint(f); return (u + 0x7fffu + ((u >> 16) & 1u)) >> 16; }
DI float bf2f(unsigned h) { return __uint_as_float(h << 16); }
typedef float f32x2_t __attribute__((ext_vector_type(2)));
typedef __bf16 bf16x2_t __attribute__((ext_vector_type(2)));
DI unsigned cvtpk_c(float lo, float hi) { const f32x2_t v = {lo, hi}; const bf16x2_t b = __builtin_convertvector(v, bf16x2_t); return __builtin_bit_cast(unsigned, b); }
DI unsigned cvtpk(float lo, float hi) { unsigned r; asm volatile("v_cvt_pk_bf16_f32 %0, %1, %2" : "=v"(r) : "v"(lo), "v"(hi)); return r; }
DI float silu_f(float x) { return x / (1.f + __expf(-x)); }
DI float wave_sum(float v) {
#pragma unroll
    for (int o = 32; o >= 1; o >>= 1) v += __shfl_xor(v, o);
    return v;
}

constexpr int NLAT = 16384, NCTXT = 512, NTOK = 16896, DM = 1024, SEQ = 8192, CTX = 256, NKEY = 8448;
constexpr int INDIM = 2720, INPAD = 2816;
constexpr int NEXP = 32, DEXP = 512;
constexpr int NSLOT = 41984;
constexpr float EPS = 1e-6f;
constexpr float AT_SCALE = 0.10206207261596575f;
constexpr float ALPHA = 1.6817928305074290f;
constexpr int NSEG = 17;

constexpr size_t al256(size_t x) { return (x + 255) / 256 * 256; }
constexpr size_t WS_CTL = 0, CTL_BYTES = 1u << 20;
constexpr size_t WS_MOD = WS_CTL + CTL_BYTES;
constexpr size_t WS_LB = WS_MOD + al256(4 * 3 * 6144 * 4);
constexpr size_t WS_ROPE = WS_LB + al256(4 * 2 * 512 * 4);
constexpr size_t WS_X = WS_ROPE + al256(2 * 8192 * 16 * 4);
constexpr size_t WS_X1 = WS_X + al256((size_t)NTOK * DM * 4);
constexpr size_t WS_H = WS_X1 + al256((size_t)NTOK * DM * 4);
constexpr size_t WS_PA = WS_H + al256((size_t)NTOK * DM * 2);
constexpr size_t WS_QH = WS_PA + al256((size_t)NTOK * 256 * 2);
constexpr size_t WS_GF = WS_QH + al256((size_t)NTOK * 512 * 2);
constexpr size_t WS_GB = WS_GF + al256((size_t)NTOK * 512 * 4);
constexpr size_t WS_VH = WS_GB + al256((size_t)NTOK * 512 * 4);
constexpr size_t WS_GATE = WS_VH + al256((size_t)NTOK * 256 * 2);
constexpr size_t WS_CQKV = WS_GATE + al256((size_t)NTOK * 256 * 2);
constexpr size_t WS_QB = WS_CQKV + al256((size_t)NTOK * 416 * 2);
constexpr size_t WS_KB = WS_QB + al256((size_t)16 * NKEY * 96 * 2);
constexpr size_t WS_VB = WS_KB + al256((size_t)16 * NKEY * 128 * 2);
constexpr size_t WS_MIX = WS_VB + al256((size_t)16 * NKEY * 64 * 2);
constexpr size_t WS_M = WS_MIX + al256((size_t)NTOK * DM * 2);
constexpr size_t WS_OLOC = WS_M + al256((size_t)NTOK * DM * 4);
constexpr size_t WS_QCUM = WS_OLOC + al256((size_t)2 * NTOK * 256 * 4);
constexpr size_t WS_SLOC = WS_QCUM + al256((size_t)2 * NTOK * 512 * 2);
constexpr size_t WS_DTOT = WS_SLOC + al256((size_t)16 * NSEG * 8192 * 4);
constexpr size_t WS_LIST = WS_DTOT + al256((size_t)16 * NSEG * 128 * 4);
constexpr size_t WS_LISTW = WS_LIST + al256((size_t)NEXP * NTOK * 4);
constexpr size_t WS_TOKSLOT = WS_LISTW + al256((size_t)NEXP * NTOK * 4);
constexpr size_t WS_ACT = WS_TOKSLOT + al256((size_t)NTOK * 16);
constexpr size_t WS_Y = WS_ACT + al256((size_t)NSLOT * 512 * 2);
constexpr size_t WS_WIN = WS_Y + al256((size_t)NSLOT * 1024 * 2);
constexpr size_t WS_WOUT = WS_WIN + al256((size_t)INPAD * 1024 * 2);
constexpr size_t WS_WUQ = WS_WOUT + al256((size_t)1024 * 1024 * 2);
constexpr size_t WS_WUKV = WS_WUQ + al256((size_t)768 * 256 * 2);
constexpr size_t WS_W13 = WS_WUKV + al256((size_t)1024 * 128 * 2);
constexpr size_t WS_W2 = WS_W13 + al256((size_t)NEXP * 1024 * 1024 * 2);
constexpr size_t WS_KF = WS_W2 + al256((size_t)NEXP * 1024 * 512 * 2);
constexpr size_t WS_KBW = WS_KF + al256((size_t)NTOK * 512 * 2);
constexpr size_t WS_POOLWT = WS_KBW + al256((size_t)NTOK * 512 * 2);
constexpr size_t WS_END = WS_POOLWT + al256((size_t)4 * 4 * 64 * 64 * 2);

constexpr int CW_BAR = 4096;
constexpr int CW_CNT = 16384;
constexpr int CW_KMAX = 24576;

constexpr int LDS_MAIN = 147456;
constexpr int LDS_BYTES = LDS_MAIN + 1024;

struct Params {
    const float* in[27];
    float* out;
    unsigned char* ws;
    int s_lo, s_hi;
};
enum { I_X = 0, I_C, I_CTX, I_CCTX, I_WMOD, I_BMOD, I_WIN, I_POOLW, I_POOLS, I_LBLOG, I_HGNG, I_QNG, I_WUQ, I_KVNG, I_WUKV, I_WOUT,
       I_LN1G, I_LN1B, I_LN2G, I_LN2B, I_RGW, I_RGB, I_REW, I_REB, I_EW1, I_EW3, I_EW2 };

#define XB_TMO      128
#define XB_XCNT(j)  (256  + 64 * (j))
#define XB_XSUB(j)  (1280 + 64 * (j))
#define XB_XGEN(j)  (2304 + 64 * (j))
#define XB_TOP      3328
#define XB_TOPGEN   3392
#define XCD_BAR_WORDS 3456
#define XB_SPIN_CAP (1u << 18)

__device__ __forceinline__ unsigned xb_ld(unsigned* p)              { return __hip_atomic_load(p, __ATOMIC_RELAXED, __HIP_MEMORY_SCOPE_AGENT); }
__device__ __forceinline__ unsigned xb_add(unsigned* p, unsigned v) { return __hip_atomic_fetch_add(p, v, __ATOMIC_RELAXED, __HIP_MEMORY_SCOPE_AGENT); }
__device__ __forceinline__ unsigned xb_xcc_id() { return (unsigned)__builtin_amdgcn_s_getreg((3 << 11) | 20) & 0xFu; }
#define XB_SPIN(cond, bar) do { unsigned _sp = 0; while (cond) { __builtin_amdgcn_s_sleep(1); \
    if ((++_sp & 255u) == 0u) { if (xb_ld(&(bar)[XB_TMO])) break; if (_sp > XB_SPIN_CAP) { atomicAdd(&(bar)[XB_TMO], 1u); break; } } } } while (0)

struct XcdBarrier { unsigned* bar; unsigned x; volatile LAS unsigned* st; };

__device__ __forceinline__ XcdBarrier xcd_barrier_post(unsigned* bar, volatile LAS unsigned* st) {
    XcdBarrier b; b.bar = bar; b.x = xb_xcc_id(); b.st = st;
    if (threadIdx.x == 0) (void)xb_add(&bar[XB_XCNT(b.x)], 1u);
    return b;
}
__device__ __forceinline__ void xcd_barrier_complete(unsigned* bar, unsigned x, unsigned& nloc, unsigned& nx) {
    const unsigned G = gridDim.x * gridDim.y * gridDim.z;
    unsigned sum, cnt, mine, sp = 0u;
    for (;;) {
        sum = 0u; cnt = 0u; mine = 0u;
#pragma unroll
        for (unsigned j = 0; j < 16; ++j) { const unsigned c = xb_ld(&bar[XB_XCNT(j)]); sum += c; cnt += (c > 0u) ? 1u : 0u; mine = (j == x) ? c : mine; }
        if (sum == G) break;
        __builtin_amdgcn_s_sleep(1);
        if ((++sp & 255u) == 0u) { if (xb_ld(&bar[XB_TMO])) break; if (sp > XB_SPIN_CAP) { atomicAdd(&bar[XB_TMO], 1u); break; } }
    }
    nloc = mine > 0u ? mine : 1u; nx = cnt > 0u ? cnt : 1u;
}
__device__ __forceinline__ void xcd_barrier(const XcdBarrier& b) {
    asm volatile("s_waitcnt vmcnt(0)" ::: "memory");
    __syncthreads();
    if (threadIdx.x == 0) {
        unsigned* bar = b.bar;
        __builtin_amdgcn_s_waitcnt(0);
        unsigned nloc = b.st[0], nx = b.st[1];
        if (nloc == 0u) { xcd_barrier_complete(bar, b.x, nloc, nx); b.st[0] = nloc; b.st[1] = nx; }
        const unsigned old = xb_add(&bar[XB_XSUB(b.x)], 1u);
        const unsigned gen = old / nloc;
        if (old + 1u == (gen + 1u) * nloc) {
            __builtin_amdgcn_fence(__ATOMIC_RELEASE, "agent");
            asm volatile("s_waitcnt vmcnt(0)" ::: "memory");
            const unsigned og = xb_add(&bar[XB_TOP], 1u);
            const unsigned tg = og / nx;
            if (og + 1u == (tg + 1u) * nx) xb_add(&bar[XB_TOPGEN], 1u);
            else XB_SPIN(xb_ld(&bar[XB_TOPGEN]) == tg, bar);
            __builtin_amdgcn_fence(__ATOMIC_ACQUIRE, "agent");
            xb_add(&bar[XB_XGEN(b.x)], 1u);
            asm volatile("s_waitcnt vmcnt(0)" ::: "memory");
        } else {
            XB_SPIN(xb_ld(&bar[XB_XGEN(b.x)]) == gen, bar);
            __builtin_amdgcn_fence(__ATOMIC_ACQUIRE, "agent");
            asm volatile("s_waitcnt vmcnt(0)" ::: "memory");
        }
    }
    __syncthreads();
}

#define GAS __attribute__((address_space(1)))
typedef GAS const float* fptr_t;
typedef __attribute__((address_space(4))) const fptr_t* kin_t;
struct Frame {
    kin_t in;
    GAS float* out;
    GAS unsigned char* ws;
    LAS unsigned char* lds;
    int tid, lane, wid, G, bid;
};
#define WSP(T, off) ((T*)(GAS T*)(F.ws + (off)))
DI const float* inp(const Frame& F, int k) { return (const float*)F.in[k]; }
#define PHASE_FRAME(Fin) Frame F = (Fin); { int _w = F.wid; asm volatile("" : "+s"(_w)); int _z = 0; asm volatile("" : "+v"(_z)); \
    F.lane = (int)__builtin_amdgcn_mbcnt_hi(~0u, __builtin_amdgcn_mbcnt_lo(~0u, (unsigned)_z)); F.wid = _w; F.tid = _w * 64 + F.lane; \
    asm volatile("" : "+s"(F.ws), "+s"(F.in), "+s"(F.out)); }

#define PHASE_FRAME2(Fin) Frame F2 = (Fin); { int _w = F2.wid; asm volatile("" : "+s"(_w)); int _z = 0; asm volatile("" : "+v"(_z)); \
    F2.lane = (int)__builtin_amdgcn_mbcnt_hi(~0u, __builtin_amdgcn_mbcnt_lo(~0u, (unsigned)_z)); F2.wid = _w; F2.tid = _w * 64 + F2.lane; }
DI int row_seq(int row) { return row < NLAT ? (row >> 13) : 2; }
DI const float* x_in_row(const Frame& F, int l, int row) {
    if (l == 0) return row < NLAT ? inp(F, I_X) + (size_t)row * DM : inp(F, I_CTX) + (size_t)(row - NLAT) * DM;
    return WSP(const float, WS_X) + (size_t)row * DM;
}

DI int lds_byte(int r, int c) { const int st = (r >> 4) * 2 + (c >> 5), rr = r & 15, cc = c & 31, ob = rr * 64 + cc * 2; return st * 1024 + (ob ^ (((ob >> 9) & 1) << 5)); }
DI void stage_rc(int b, int& R, int& C) { const int st = b / 1024, sb = b % 1024, swz = sb ^ (((sb >> 9) & 1) << 5); R = (st >> 1) * 16 + swz / 64; C = (st & 1) * 32 + (swz % 64) / 2; }

struct GemmTile {
    const bf16_t* A; int lda; const int* rowidx; int nvalid; long arow0;
    const bf16_t* Bt; int ldb; long brow0;
    int K;
};
constexpr int GT_STAGE = 49152;

template <bool SSQ>
DI void gemm_tile(const Frame& F, const GemmTile& g, f32x4 (&acc)[4][4], float (&ssq)[4]) {
    const int tid = F.tid, wid = F.wid, lane = F.lane, wr = wid >> 1, wc = wid & 1, fr = lane & 15, fq = lane >> 4;
    LAS unsigned char* lds = F.lds;
    long aoff[2][2], boff[2];
#pragma unroll
    for (int i = 0; i < 2; ++i) {
        int R, C; stage_rc(tid * 16 + i * 8192, R, C);
#pragma unroll
        for (int h = 0; h < 2; ++h) {
            const int rr = h * 128 + R;
            long grow;
            if (g.rowidx) grow = (rr < g.nvalid) ? (long)g.rowidx[rr] : 0L; else grow = g.arow0 + rr;
            aoff[h][i] = grow * g.lda + C;
        }
        boff[i] = (g.brow0 + R) * g.ldb + C;
    }
#pragma unroll
    for (int m = 0; m < 4; ++m) {
        ssq[m] = 0.f;
#pragma unroll
        for (int n = 0; n < 4; ++n) acc[m][n] = (f32x4){0.f, 0.f, 0.f, 0.f};
    }
    const unsigned ldsw = (unsigned)wid * 1024u;
    const int a_rd = (wr >> 1) * 16384 + lds_byte((wr & 1) * 64 + fr, fq * 8);
    const int b_rd = 32768 + lds_byte(wc * 64 + fr, fq * 8);
#define GT_ISSUE(t, s) do { _Pragma("unroll") for (int _h = 0; _h < 2; ++_h) _Pragma("unroll") for (int _i = 0; _i < 2; ++_i) \
        __builtin_amdgcn_global_load_lds((const unsigned*)(g.A + aoff[_h][_i] + (t) * 64), (LAS unsigned*)(lds + (s) * GT_STAGE + _h * 16384 + ldsw + _i * 8192), 16, 0, 0); \
        _Pragma("unroll") for (int _i = 0; _i < 2; ++_i) \
        __builtin_amdgcn_global_load_lds((const unsigned*)(g.Bt + boff[_i] + (t) * 64), (LAS unsigned*)(lds + (s) * GT_STAGE + 32768 + ldsw + _i * 8192), 16, 0, 0); } while (0)
    const int nt = g.K >> 6;
    __builtin_amdgcn_s_barrier();
    GT_ISSUE(0, 0);
    for (int t = 0; t < nt; ++t) {
        const int cur = t & 1;
        if (t + 1 < nt) {
            __builtin_amdgcn_s_barrier();
            GT_ISSUE(t + 1, cur ^ 1);
            asm volatile("s_waitcnt vmcnt(6)" ::: "memory");
        } else {
            asm volatile("s_waitcnt vmcnt(0)" ::: "memory");
        }
        __builtin_amdgcn_s_barrier();
        LAS unsigned char* sb = lds + cur * GT_STAGE;
#pragma unroll
        for (int ks = 0; ks < 2; ++ks) {
            bf16x8 af[4], bfr[4];
#pragma unroll
            for (int m = 0; m < 4; ++m) af[m] = *(const LAS bf16x8*)(sb + a_rd + m * 2048 + ks * 1024);
#pragma unroll
            for (int n = 0; n < 4; ++n) bfr[n] = *(const LAS bf16x8*)(sb + b_rd + n * 2048 + ks * 1024);
            if (SSQ) {
#pragma unroll
                for (int m = 0; m < 4; ++m)
#pragma unroll
                    for (int j = 0; j < 8; ++j) { const float v = bf2f((unsigned)(unsigned short)af[m][j]); ssq[m] = fmaf(v, v, ssq[m]); }
            }
#pragma unroll
            for (int m = 0; m < 4; ++m)
#pragma unroll
                for (int n = 0; n < 4; ++n) acc[m][n] = __builtin_amdgcn_mfma_f32_16x16x32_bf16(bfr[n], af[m], acc[m][n], 0, 0, 0);
        }
    }
#undef GT_ISSUE
    if (SSQ) {
#pragma unroll
        for (int m = 0; m < 4; ++m) { ssq[m] += __shfl_xor(ssq[m], 16); ssq[m] += __shfl_xor(ssq[m], 32); }
    }
}

DI void row_load(const float* p, int lane, float (&v)[16]) {
#pragma unroll
    for (int i = 0; i < 4; ++i) { const f32x4 t = *(const f32x4*)(p + lane * 4 + i * 256); v[4 * i] = t[0]; v[4 * i + 1] = t[1]; v[4 * i + 2] = t[2]; v[4 * i + 3] = t[3]; }
}
DI void row_store(float* p, int lane, const float (&v)[16]) {
#pragma unroll
    for (int i = 0; i < 4; ++i) *(f32x4*)(p + lane * 4 + i * 256) = (f32x4){v[4 * i], v[4 * i + 1], v[4 * i + 2], v[4 * i + 3]};
}
DI void row_store_bf16(bf16_t* p, int lane, const float (&v)[16]) {
#pragma unroll
    for (int i = 0; i < 4; ++i) *(u32x2*)(p + lane * 4 + i * 256) = (u32x2){cvtpk(v[4 * i], v[4 * i + 1]), cvtpk(v[4 * i + 2], v[4 * i + 3])};
}
DI void row_ln(float (&v)[16]) {
    float s = 0.f;
#pragma unroll
    for (int i = 0; i < 16; ++i) s += v[i];
    const float mu = wave_sum(s) * (1.f / 1024.f);
    float q = 0.f;
#pragma unroll
    for (int i = 0; i < 16; ++i) { v[i] -= mu; q = fmaf(v[i], v[i], q); }
    const float rs = rsqrtf(wave_sum(q) * (1.f / 1024.f) + EPS);
#pragma unroll
    for (int i = 0; i < 16; ++i) v[i] *= rs;
}

struct CvtJob { const float* src; int ldsrc, N, k0, n0; bf16_t* dst; int lddst, dmode; const float* scale; };
DI bool cvt_job(const Frame& F, int l, int u, CvtJob& j) {
    constexpr int U_WIN = 16 * 11, U_WOUT = 16 * 4, U_WUQ = 4 * 3, U_WUKV = 2 * 4, U_E13 = 32 * 16 * 2, U_E2 = 32 * 8 * 4;
    constexpr int O1 = U_WIN, O2 = O1 + U_WOUT, O3 = O2 + U_WUQ, O4 = O3 + U_WUKV, O5 = O4 + U_E13, O6 = O5 + U_E13, O7 = O6 + U_E2;
    if (u >= O7) return false;
    j.scale = nullptr; j.dmode = 0;
    if (u < O1) { j.src = inp(F, I_WIN) + (size_t)l * 1024 * INDIM; j.ldsrc = INDIM; j.N = INDIM; j.k0 = (u / 11) * 64; j.n0 = (u % 11) * 256; j.dst = WSP(bf16_t, WS_WIN); j.lddst = 1024; }
    else if (u < O2) { const int v = u - O1; j.src = inp(F, I_WOUT) + (size_t)l * 1024 * 1024; j.ldsrc = 1024; j.N = 1024; j.k0 = (v / 4) * 64; j.n0 = (v % 4) * 256; j.dst = WSP(bf16_t, WS_WOUT); j.lddst = 1024; }
    else if (u < O3) { const int v = u - O2; j.src = inp(F, I_WUQ) + (size_t)l * 256 * 768; j.ldsrc = 768; j.N = 768; j.k0 = (v / 3) * 64; j.n0 = (v % 3) * 256; j.dst = WSP(bf16_t, WS_WUQ); j.lddst = 256; j.scale = inp(F, I_QNG) + l * 256; }
    else if (u < O4) { const int v = u - O3; j.src = inp(F, I_WUKV) + (size_t)l * 128 * 1024; j.ldsrc = 1024; j.N = 1024; j.k0 = (v / 4) * 64; j.n0 = (v % 4) * 256; j.dst = WSP(bf16_t, WS_WUKV); j.lddst = 128; j.scale = inp(F, I_KVNG) + l * 128; }
    else if (u < O6) { const bool w3 = u >= O5; const int v = u - (w3 ? O5 : O4), e = v / 32, w = v % 32;
        j.src = inp(F, w3 ? I_EW3 : I_EW1) + ((size_t)l * NEXP + e) * 1024 * 512; j.ldsrc = 512; j.N = 512; j.k0 = (w / 2) * 64; j.n0 = (w % 2) * 256; j.dst = WSP(bf16_t, WS_W13) + (size_t)e * 1024 * 1024; j.lddst = 1024; j.dmode = w3 ? 2 : 1; }
    else { const int v = u - O6, e = v / 32, w = v % 32;
        j.src = inp(F, I_EW2) + ((size_t)l * NEXP + e) * 512 * 1024; j.ldsrc = 1024; j.N = 1024; j.k0 = (w / 4) * 64; j.n0 = (w % 4) * 256; j.dst = WSP(bf16_t, WS_W2) + (size_t)e * 1024 * 512; j.lddst = 512; }
    return true;
}
DI void phase_convert(const Frame& F, int l) {
    const int tid = F.tid, lr = tid >> 6, lc4 = (tid & 63) * 4;
    LAS float* T0 = (LAS float*)F.lds;
    f32x4 rg[8];
    CvtJob cj, nj;
    int u = F.bid;
    bool have = cvt_job(F, l, u, cj);
#define CV_LOAD(J) do { _Pragma("unroll") for (int q = 0; q < 8; ++q) { const int k = lr + 8 * q, n = (J).n0 + lc4; f32x4 v = (f32x4){0.f, 0.f, 0.f, 0.f}; \
        if (n < (J).N) v = *(const f32x4*)((J).src + (size_t)((J).k0 + k) * (J).ldsrc + n); if ((J).scale) v = v * (J).scale[(J).k0 + k]; rg[q] = v; } } while (0)
    __syncthreads();
    if (have) CV_LOAD(cj);
    int p = 0;
    while (have) {
        LAS float* T = T0 + p * (64 * 257);
#pragma unroll
        for (int q = 0; q < 8; ++q) { const int k = lr + 8 * q; T[k * 257 + lc4 + 0] = rg[q][0]; T[k * 257 + lc4 + 1] = rg[q][1]; T[k * 257 + lc4 + 2] = rg[q][2]; T[k * 257 + lc4 + 3] = rg[q][3]; }
        u += F.G;
        const bool hn = cvt_job(F, l, u, nj);
        if (hn) CV_LOAD(nj);
        __syncthreads();
        {
            const int n = tid >> 1, kh = (tid & 1) * 32;
            const int nn = cj.n0 + n;
            const int drow = cj.dmode == 0 ? nn : (32 * (nn >> 4) + (nn & 15) + (cj.dmode == 2 ? 16 : 0));
            bf16_t* dp = cj.dst + (size_t)drow * cj.lddst + cj.k0 + kh;
#pragma unroll
            for (int g = 0; g < 4; ++g) {
                float v[8];
#pragma unroll
                for (int jj = 0; jj < 8; ++jj) v[jj] = T[(kh + g * 8 + jj) * 257 + n];
                *(u32x4*)(dp + g * 8) = (u32x4){cvtpk(v[0], v[1]), cvtpk(v[2], v[3]), cvtpk(v[4], v[5]), cvtpk(v[6], v[7])};
            }
        }
        cj = nj; have = hn; p ^= 1;
    }
#undef CV_LOAD
    __syncthreads();
}

DI void phase_setup(const Frame& Fin) {
    PHASE_FRAME(Fin);
    const int tid = F.tid, lane = F.lane, wid = F.wid;
    {
        LAS float* act = (LAS float*)F.lds;
        LAS float* red = (LAS float*)(F.lds + 12288);
        for (int i = tid; i < 3072; i += 512) { const int s = i >> 10, k = i & 1023; const float v = s < 2 ? inp(F, I_C)[s * 1024 + k] : inp(F, I_CCTX)[k]; act[i] = silu_f(v); }
        __syncthreads();
        for (int u = F.bid; u < 96; u += F.G) {
            const int l = u / 24, cg = u % 24, col = cg * 256 + lane * 4;
            const float* W = inp(F, I_WMOD) + (size_t)l * 1024 * 6144 + col;
            f32x4 a0 = (f32x4){0.f, 0.f, 0.f, 0.f}, a1 = a0, a2 = a0;
            for (int k = wid * 128; k < wid * 128 + 128; ++k) {
                const f32x4 w = *(const f32x4*)(W + (size_t)k * 6144);
                a0 += w * act[k]; a1 += w * act[1024 + k]; a2 += w * act[2048 + k];
            }
#pragma unroll
            for (int j = 0; j < 4; ++j) { red[(wid * 3 + 0) * 256 + lane * 4 + j] = a0[j]; red[(wid * 3 + 1) * 256 + lane * 4 + j] = a1[j]; red[(wid * 3 + 2) * 256 + lane * 4 + j] = a2[j]; }
            __syncthreads();
            for (int i = tid; i < 768; i += 512) {
                const int s = i >> 8, c = i & 255;
                float sum = 0.f;
#pragma unroll
                for (int w = 0; w < 8; ++w) sum += red[(w * 3 + s) * 256 + c];
                WSP(float, WS_MOD)[((size_t)l * 3 + s) * 6144 + cg * 256 + c] = sum + inp(F, I_BMOD)[l * 6144 + cg * 256 + c];
            }
            __syncthreads();
        }
    }
    if (F.bid == F.G - 1) {
        for (int i = tid; i < 1024; i += 512) {
            float z[4], mx = -1e30f;
#pragma unroll
            for (int l = 0; l < 4; ++l) { z[l] = inp(F, I_LBLOG)[l * 1024 + i]; mx = fmaxf(mx, z[l]); }
            float e[4], s = 0.f;
#pragma unroll
            for (int l = 0; l < 4; ++l) { e[l] = expf(z[l] - mx); s += e[l]; }
            float c = 0.f;
#pragma unroll
            for (int l = 0; l < 4; ++l) { if (l > 0) c += e[l] / s; WSP(float, WS_LB)[l * 1024 + i] = c; }
        }
    }
    {
        const int i = F.bid * 512 + tid;
        for (int idx = i; idx < 8192 * 16; idx += F.G * 512) {
            const int t = idx >> 4, ax = (idx >> 3) & 1, f = idx & 7;
            const double fr = f == 0 ? 1.0 : f == 1 ? 0.31622776601683794 : f == 2 ? 0.1 : f == 3 ? 0.031622776601683794 : f == 4 ? 0.01 : f == 5 ? 0.0031622776601683794 : f == 6 ? 0.001 : 0.00031622776601683794;
            const double pos = (double)(ax == 0 ? (t >> 6) : (t & 63));
            const double ang = pos * fr;
            const double n = __builtin_rint(ang * 0.63661977236758134308);
            double r = __builtin_fma(-n, 1.5707963267948966192, ang);
            r = __builtin_fma(-n, 6.123233995736766036e-17, r);
            const double r2 = r * r;
            double sp = 1.0 / 6227020800.0; sp = sp * r2 - 1.0 / 39916800.0; sp = sp * r2 + 1.0 / 362880.0; sp = sp * r2 - 1.0 / 5040.0; sp = sp * r2 + 1.0 / 120.0; sp = sp * r2 - 1.0 / 6.0; sp = sp * r2 + 1.0;
            const double sn = r * sp;
            double cp = -1.0 / 87178291200.0; cp = cp * r2 + 1.0 / 479001600.0; cp = cp * r2 - 1.0 / 3628800.0; cp = cp * r2 + 1.0 / 40320.0; cp = cp * r2 - 1.0 / 720.0; cp = cp * r2 + 1.0 / 24.0; cp = cp * r2 - 0.5; cp = cp * r2 + 1.0;
            const int qd = ((int)n) & 3;
            double cs, ss;
            if (qd == 0) { cs = cp; ss = sn; } else if (qd == 1) { cs = -sn; ss = cp; } else if (qd == 2) { cs = -cp; ss = -sn; } else { cs = sn; ss = -cp; }
            WSP(float, WS_ROPE)[idx] = (float)cs;
            WSP(float, WS_ROPE)[8192 * 16 + idx] = (float)ss;
        }
    }
    for (int i = F.bid * 512 + tid; i < 4 * 4 * 64 * 64; i += F.G * 512) {
        const int c = i & 63, d = (i >> 6) & 63, lg = i >> 12;
        WSP(bf16_t, WS_POOLWT)[i] = (bf16_t)f2bf(inp(F, I_POOLW)[(size_t)lg * 4096 + c * 64 + d]);
    }
    phase_convert(F, 0);
}

DI void phase_mod0(const Frame& Fin) {
    PHASE_FRAME(Fin);
    const int lane = F.lane;
    for (int row = F.bid * 8 + F.wid; row < NTOK; row += F.G * 8) {
        float v[16]; row_load(x_in_row(F, 0, row), lane, v); row_ln(v);
        const float* md = WSP(const float, WS_MOD) + (size_t)(0 * 3 + row_seq(row)) * 6144;
        float sh[16], sc[16]; row_load(md, lane, sh); row_load(md + 1024, lane, sc);
#pragma unroll
        for (int i = 0; i < 16; ++i) v[i] = fmaf(v[i], 1.f + sc[i], sh[i]);
        row_store_bf16(WSP(bf16_t, WS_H) + (size_t)row * DM, lane, v);
    }
}

namespace g8 {
constexpr int HALF = 128, HTB = 16384;
struct Unit { int pm, pn; const char* A; const char* B; const int* rowidx; int nvalid; };
template <bool GATHER, class Sched, class Epi>
DI void gemm8(const Frame& F, const int K, const Sched& S, const Epi& E) {
    LAS unsigned char* lds = F.lds;
    const int tid = F.tid, wid = F.wid, lane = F.lane, wr = wid >> 2, wc = wid & 3, fr = lane & 15, fq = lane >> 4;
    const int nt = K >> 6;
    unsigned voffA[2][2], nvoffA[2][2], voffB[2];
#pragma unroll
    for (int i = 0; i < 2; ++i) { int sR, sC; stage_rc(tid * 16 + i * 8192, sR, sC); voffB[i] = (unsigned)(sR * K + sC) * 2u; }
    const size_t kstep = 128, hstep = (size_t)HALF * K * 2;
    const unsigned ldsw = (unsigned)wid * 1024u;
    const int aoff = lds_byte(wr * 64 + fr, fq * 8), boff = lds_byte(wc * 32 + fr, fq * 8);
#define G8_SA(b, h) (((b) * 2 + (h)) * HTB)
#define G8_SB(b, h) ((4 + (b) * 2 + (h)) * HTB)
#define G8_STAGE(bufoff, gbase, voff) do { _Pragma("unroll") for (int _i = 0; _i < 2; ++_i) \
        __builtin_amdgcn_global_load_lds((const unsigned*)((const char*)(gbase) + (voff)[_i]), (LAS unsigned*)(lds + (bufoff) + ldsw + _i * 8192), 16, 0, 0); } while (0)
#define G8_LDA(dst, b, h) do { _Pragma("unroll") for (int m = 0; m < 4; ++m) _Pragma("unroll") for (int k = 0; k < 2; ++k) dst[m][k] = *(const LAS bf16x8*)(lds + G8_SA(b, h) + aoff + m * 2048 + k * 1024); } while (0)
#define G8_LDB(dst, b, h) do { _Pragma("unroll") for (int n = 0; n < 2; ++n) _Pragma("unroll") for (int k = 0; k < 2; ++k) dst[n][k] = *(const LAS bf16x8*)(lds + G8_SB(b, h) + boff + n * 2048 + k * 1024); } while (0)
#define G8_MMA(ai, bj, At, Bt) do { __builtin_amdgcn_s_setprio(1); _Pragma("unroll") for (int m = 0; m < 4; ++m) _Pragma("unroll") for (int n = 0; n < 2; ++n) _Pragma("unroll") for (int k = 0; k < 2; ++k) \
        acc[ai][bj][m][n] = __builtin_amdgcn_mfma_f32_16x16x32_bf16(Bt[n][k], At[m][k], acc[ai][bj][m][n], 0, 0, 0); __builtin_amdgcn_s_setprio(0); } while (0)
#define G8_WAIT_V(n) asm volatile("s_waitcnt vmcnt(" #n ")" ::: "memory")
#define G8_WAIT_L(n) asm volatile("s_waitcnt lgkmcnt(" #n ")" ::: "memory")
#define G8_BAR __builtin_amdgcn_s_barrier()
#define G8_SCHED __builtin_amdgcn_sched_barrier(0)
#define G8_VOFF(dst, u) do { int _tz = tid; asm volatile("" : "+v"(_tz)); _Pragma("unroll") for (int _i = 0; _i < 2; ++_i) { int _sR, _sC; stage_rc(_tz * 16 + _i * 8192, _sR, _sC); \
        _Pragma("unroll") for (int _h = 0; _h < 2; ++_h) { const int _rr = _h * HALF + _sR; \
        if (GATHER) { const int _row = (_rr < (u).nvalid) ? (u).rowidx[_rr] : 0; dst[_h][_i] = (unsigned)(_row * K + _sC) * 2u; } else dst[_h][_i] = (unsigned)(_rr * K + _sC) * 2u; } } } while (0)
    Unit cur, nxt; int ui = 0;
    (void)S.next(0, cur);
    f32x4 acc[2][2][4][2];
#define G8_ZERO() do { _Pragma("unroll") for (int a = 0; a < 2; ++a) _Pragma("unroll") for (int b = 0; b < 2; ++b) _Pragma("unroll") for (int m = 0; m < 4; ++m) _Pragma("unroll") for (int n = 0; n < 2; ++n) acc[a][b][m][n] = (f32x4){0.f, 0.f, 0.f, 0.f}; } while (0)
    G8_ZERO();
    bf16x8 At[4][2], B0[2][2], B1[2][2];
    G8_VOFF(voffA, cur);
    const char* cA = cur.A; const char* cB = cur.B;
    __builtin_amdgcn_s_barrier();
    G8_STAGE(G8_SB(0, 0), cB, voffB); G8_STAGE(G8_SB(0, 1), cB + hstep, voffB); G8_STAGE(G8_SA(0, 0), cA, voffA[0]); G8_STAGE(G8_SA(0, 1), cA, voffA[1]);
    if (wr == 1) G8_BAR;
    G8_WAIT_V(2); G8_BAR;
    G8_STAGE(G8_SB(1, 0), cB + kstep, voffB); G8_STAGE(G8_SA(1, 0), cA + kstep, voffA[0]); G8_STAGE(G8_SB(1, 1), cB + hstep + kstep, voffB);
    G8_WAIT_V(6); G8_BAR;
    for (;;) {
        const int has_next = __builtin_amdgcn_readfirstlane(S.next(ui + 1, nxt) ? 1 : 0);
        const char* nA = has_next ? nxt.A : cA; const char* nB = has_next ? nxt.B : cB;
        if (GATHER) { if (has_next) G8_VOFF(nvoffA, nxt); else {
#pragma unroll
            for (int h = 0; h < 2; ++h) { nvoffA[h][0] = voffA[h][0]; nvoffA[h][1] = voffA[h][1]; } } }
        for (int t = 0; t < nt; t += 2) {
            const bool last = (t == nt - 2);
            const char* a1 = cA + (size_t)(t + 1) * kstep;
            const char* a2 = last ? nA : cA + (size_t)(t + 2) * kstep; const char* b2 = last ? nB : cB + (size_t)(t + 2) * kstep;
            const char* a3 = a2 + kstep; const char* b3 = b2 + kstep;
            unsigned vA2[2][2];
#pragma unroll
            for (int h = 0; h < 2; ++h) { vA2[h][0] = (GATHER && last) ? nvoffA[h][0] : voffA[h][0]; vA2[h][1] = (GATHER && last) ? nvoffA[h][1] : voffA[h][1]; }
            G8_LDB(B0, 0, 0); G8_LDB(B1, 0, 1); G8_SCHED; G8_LDA(At, 0, 0); G8_STAGE(G8_SA(1, 1), a1, voffA[1]);
            G8_WAIT_V(8); G8_WAIT_L(0); G8_BAR; G8_MMA(0, 0, At, B0); G8_MMA(0, 1, At, B1); G8_BAR; G8_SCHED;
            G8_LDA(At, 0, 1); G8_STAGE(G8_SB(0, 0), b2, voffB); G8_STAGE(G8_SB(0, 1), b2 + hstep, voffB); G8_STAGE(G8_SA(0, 0), a2, vA2[0]);
            G8_WAIT_V(8); G8_WAIT_L(0); G8_BAR; G8_MMA(1, 0, At, B0); G8_MMA(1, 1, At, B1); G8_BAR; G8_SCHED;
            G8_LDB(B0, 1, 0); G8_LDB(B1, 1, 1); G8_SCHED; G8_LDA(At, 1, 0); G8_STAGE(G8_SA(0, 1), a2, vA2[1]);
            G8_WAIT_V(8); G8_WAIT_L(0); G8_BAR; G8_MMA(0, 0, At, B0); G8_MMA(0, 1, At, B1); G8_BAR; G8_SCHED;
            G8_LDA(At, 1, 1); G8_STAGE(G8_SB(1, 0), b3, voffB); G8_STAGE(G8_SB(1, 1), b3 + hstep, voffB); G8_STAGE(G8_SA(1, 0), a3, vA2[0]);
            G8_WAIT_V(8); G8_WAIT_L(0); G8_BAR; G8_MMA(1, 0, At, B0); G8_MMA(1, 1, At, B1); G8_BAR; G8_SCHED;
        }
        {
            int tz = tid; asm volatile("" : "+v"(tz));
            const int wz = __builtin_amdgcn_readfirstlane(tz >> 6), lz = tz & 63;
            E(acc, cur, wz >> 2, wz & 3, lz & 15, lz >> 4);
        }
        if (!has_next) break;
        G8_ZERO();
        cur = nxt; cA = nA; cB = nB; ++ui;
        if (GATHER) {
#pragma unroll
            for (int h = 0; h < 2; ++h) { voffA[h][0] = nvoffA[h][0]; voffA[h][1] = nvoffA[h][1]; } }
    }
    G8_WAIT_V(0);
    if (wr == 0) G8_BAR;
    G8_BAR;
#undef G8_SA
#undef G8_SB
#undef G8_STAGE
#undef G8_LDA
#undef G8_LDB
#undef G8_MMA
#undef G8_WAIT_V
#undef G8_WAIT_L
#undef G8_BAR
#undef G8_SCHED
#undef G8_VOFF
#undef G8_ZERO
}
struct DenseSched {
    int nM, nN, nwg, G, c; const char* A; const char* B; size_t tstepA, tstepB;
    DI void init(int M, int N, int K, int G_, int c_, const void* A_, const void* B_) { nM = M / 256; nN = N / 256; nwg = nM * nN; G = G_; c = c_; A = (const char*)A_; B = (const char*)B_; tstepA = (size_t)256 * K * 2; tstepB = tstepA; }
    DI bool next(int i, Unit& u) const {
        const long L = (long)i * G + c; if (L >= nwg) return false;
        int wgid = (int)L; { const int q = nwg / 8, r = nwg % 8, xcd = wgid % 8, off = wgid / 8; wgid = (xcd < r ? xcd * (q + 1) : r * (q + 1) + (xcd - r) * q) + off; }
        const int nig = 8 * nN, gid = wgid / nig, fm = gid * 8, gsz = (nM - fm) < 8 ? (nM - fm) : 8;
        u.pm = fm + ((wgid % nig) % gsz); u.pn = (wgid % nig) / gsz; u.A = A + (size_t)u.pm * tstepA; u.B = B + (size_t)u.pn * tstepB; u.rowidx = nullptr; u.nvalid = 0; return true;
    }
};
}

DI void gate_gk(float z, float lb, float& g, float& k) {
    k = (1.f - lb) * __builtin_amdgcn_rcpf(1.f + __expf(z));
    g = fmaxf(__logf(1.f - k), -80.f);
}
#define PKV2(v) (u32x2){cvtpk((v)[0], (v)[1]), cvtpk((v)[2], (v)[3])}
struct EpiProj {
    Frame F; const float* lbt;
#define FOR_AMN _Pragma("unroll") for (int ai = 0; ai < 2; ++ai) _Pragma("unroll") for (int m = 0; m < 4; ++m) _Pragma("unroll") for (int n = 0; n < 2; ++n)
#define ROW_ ((size_t)u.pm * 256 + ai * 128 + wr * 64 + m * 16 + fr)
    template <int bj> DI void half(const f32x4 (&acc)[2][2][4][2], const g8::Unit& u, int wr, int wc, int fr, int fq) const {
        const int c32 = u.pn * 256 + bj * 128 + wc * 32;
        if (c32 < 256) { FOR_AMN { const f32x4 v = acc[ai][bj][m][n] * 1.0f; *(u32x2*)(WSP(bf16_t, WS_PA) + ROW_ * 256 + c32 + n * 16 + fq * 4) = PKV2(v); } }
        else if (c32 < 768) { FOR_AMN { const f32x4 v = acc[ai][bj][m][n]; const f32x4 sv = (f32x4){silu_f(v[0]), silu_f(v[1]), silu_f(v[2]), silu_f(v[3])};
            *(u32x2*)(WSP(bf16_t, WS_QH) + ROW_ * 512 + (c32 - 256) + n * 16 + fq * 4) = PKV2(sv); } }
        else if (c32 < 1792) {
            const bool bw = c32 >= 1280; const int cb = c32 - (bw ? 1280 : 768);
            float* Gp = WSP(float, bw ? WS_GB : WS_GF); bf16_t* Kp = WSP(bf16_t, bw ? WS_KBW : WS_KF);
            const float* lbp = lbt + (bw ? 512 : 0) + cb + fq * 4;
            FOR_AMN { const f32x4 v = acc[ai][bj][m][n]; const f32x4 lb = *(const f32x4*)(lbp + n * 16);
                f32x4 gg, kk;
#pragma unroll
                for (int j = 0; j < 4; ++j) { float g_, k_; gate_gk(v[j], lb[j], g_, k_); gg[j] = g_; kk[j] = k_; }
                *(f32x4*)(Gp + ROW_ * 512 + cb + n * 16 + fq * 4) = gg;
                *(u32x2*)(Kp + ROW_ * 512 + cb + n * 16 + fq * 4) = PKV2(kk); } }
        else if (c32 < 2048) { FOR_AMN { const f32x4 v = acc[ai][bj][m][n] * 1.0f; *(u32x2*)(WSP(bf16_t, WS_VH) + ROW_ * 256 + (c32 - 1792) + n * 16 + fq * 4) = PKV2(v); } }
        else if (c32 < 2304) { FOR_AMN { const f32x4 v = acc[ai][bj][m][n]; const f32x4 sv = (f32x4){silu_f(v[0]), silu_f(v[1]), silu_f(v[2]), silu_f(v[3])};
            *(u32x2*)(WSP(bf16_t, WS_GATE) + ROW_ * 256 + (c32 - 2048) + n * 16 + fq * 4) = PKV2(sv); } }
        else if (c32 < INDIM) { FOR_AMN { const f32x4 v = acc[ai][bj][m][n] * 1.0f; *(u32x2*)(WSP(bf16_t, WS_CQKV) + ROW_ * 416 + (c32 - 2304) + n * 16 + fq * 4) = PKV2(v); } }
    }
    DI void operator()(const f32x4 (&acc)[2][2][4][2], const g8::Unit& u, int wr, int wc, int fr, int fq) const {
        half<0>(acc, u, wr, wc, fr, fq); half<1>(acc, u, wr, wc, fr, fq);
    }
};
DI void phase_proj(const Frame& Fin, int l) {
    PHASE_FRAME(Fin);
    g8::DenseSched S; S.init(NTOK, INPAD, 1024, F.G, F.bid, WSP(const bf16_t, WS_H), WSP(const bf16_t, WS_WIN));
    EpiProj E; E.F = F; E.lbt = WSP(const float, WS_LB) + l * 1024;
    g8::gemm8<false>(F, 1024, S, E);
}

constexpr int HS_QT = 0, HS_KT = 8704, HS_KHT = 17408, HS_VT = 27648, HS_SB = 32768, HS_P = 50176, HS_B31 = 52736, HS_END = 53248;
constexpr int HS_LD = 136, HS_LD2 = 40;
DI void hgrn_scan_unit(const Frame& F, int unit) {
    const int tid = F.tid, lane = F.lane, wid = F.wid, fr = lane & 15, fq = lane >> 4;
    LAS unsigned char* L = F.lds;
    LAS bf16_t* QT = (LAS bf16_t*)(L + HS_QT); LAS bf16_t* KT = (LAS bf16_t*)(L + HS_KT); LAS bf16_t* KHT = (LAS bf16_t*)(L + HS_KHT);
    LAS bf16_t* VT = (LAS bf16_t*)(L + HS_VT); LAS bf16_t* SB = (LAS bf16_t*)(L + HS_SB); LAS bf16_t* PP = (LAS bf16_t*)(L + HS_P); LAS float* B31 = (LAS float*)(L + HS_B31);
    const int chain = unit / NSEG, seg = unit % NSEG;
    const int b = chain >> 3, hh = (chain >> 1) & 3, dir = chain & 1;
    const int len = seg == 0 ? 256 : 512, nchunk = len >> 5;
    const int t0 = seg == 0 ? 0 : (dir == 0 ? (seg - 1) * 512 : SEQ - seg * 512);
    const size_t rowbase = seg == 0 ? (size_t)NLAT + b * CTX : (size_t)b * SEQ;
    const float* G = WSP(const float, dir ? WS_GB : WS_GF);
    const bf16_t* KK = WSP(const bf16_t, dir ? WS_KBW : WS_KF);
    const bf16_t* QH = WSP(const bf16_t, WS_QH);
    const bf16_t* VH = WSP(const bf16_t, WS_VH);
    float* OL = WSP(float, WS_OLOC) + (size_t)dir * NTOK * 256;
    bf16_t* QC = WSP(bf16_t, WS_QCUM) + (size_t)dir * NTOK * 512;
    const int dl = lane & 15, tq = lane >> 4, d = wid * 16 + dl;
    __syncthreads();
    for (int i = tid; i < (HS_P - HS_SB) / 4; i += 512) ((LAS unsigned*)(L + HS_SB))[i] = 0u;
    f32x4 accS[4];
#pragma unroll
    for (int et = 0; et < 4; ++et) accS[et] = (f32x4){0.f, 0.f, 0.f, 0.f};
    float B0 = 0.f;
    float gq[8]; unsigned qq[8], kq[8], vv[4];
#define HS_ROW(p) (rowbase + (size_t)(dir ? (t0 + len - 1 - (p)) : (t0 + (p))))
#define HS_LOAD(c) do { _Pragma("unroll") for (int k = 0; k < 8; ++k) { const size_t r_ = HS_ROW((c) * 32 + tq * 8 + k); \
        gq[k] = G[r_ * 512 + hh * 128 + d]; qq[k] = QH[r_ * 512 + hh * 128 + d]; kq[k] = KK[r_ * 512 + hh * 128 + d]; } \
        _Pragma("unroll") for (int k = 0; k < 4; ++k) { const size_t r_ = HS_ROW((c) * 32 + wid * 4 + k); vv[k] = VH[r_ * 256 + hh * 64 + lane]; } } while (0)
    HS_LOAD(0);
    for (int c = 0; c < nchunk; ++c) {
        {
            float bl[8]; float run = 0.f;
#pragma unroll
            for (int k = 0; k < 8; ++k) { run += gq[k]; bl[k] = run; }
            const float a0 = __shfl(run, dl), a1 = __shfl(run, 16 + dl), a2 = __shfl(run, 32 + dl), a3 = __shfl(run, 48 + dl);
            const float pre = (tq > 0 ? a0 : 0.f) + (tq > 1 ? a1 : 0.f) + (tq > 2 ? a2 : 0.f);
            const float b31 = (a0 + a1) + (a2 + a3);
            const float eB0 = __expf(B0);
            unsigned khp[4];
            float khprev = 0.f;
#pragma unroll
            for (int k = 0; k < 8; ++k) {
                const float bb = pre + bl[k];
                const float qv_ = bf2f(qq[k]), kv_ = bf2f(kq[k]);
                const float qt = qv_ * __expf(bb);
                const float kt = kv_ * __expf(fminf(-bb, 80.f));
                const float kh = kv_ * __expf(b31 - bb);
                const int i = tq * 8 + k;
                QT[i * HS_LD + d] = (bf16_t)f2bf(qt);
                KT[i * HS_LD + d] = (bf16_t)f2bf(kt);
                if (k & 1) khp[k >> 1] = cvtpk(khprev, kh); else khprev = kh;
                QC[HS_ROW(c * 32 + i) * 512 + hh * 128 + d] = (bf16_t)f2bf(qt * eB0);
            }
            *(LAS u32x4*)(KHT + d * HS_LD2 + tq * 8) = (u32x4){khp[0], khp[1], khp[2], khp[3]};
            if (tq == 0) B31[d] = b31;
            *(LAS u32x2*)(VT + lane * HS_LD2 + wid * 4) = (u32x2){vv[0] | (vv[1] << 16), vv[2] | (vv[3] << 16)};
            B0 += b31;
        }
        if (c + 1 < nchunk) HS_LOAD(c + 1);
        __syncthreads();
        const int it = wid >> 2, et = wid & 3;
        f32x4 accO = (f32x4){0.f, 0.f, 0.f, 0.f};
        {
            const int pit = wid >> 1, pjt = wid & 1;
            f32x4 accP = (f32x4){0.f, 0.f, 0.f, 0.f};
#pragma unroll
            for (int ks = 0; ks < 4; ++ks) {
                const bf16x8 qf = *(const LAS bf16x8*)(QT + (it * 16 + fr) * HS_LD + ks * 32 + fq * 8);
                const bf16x8 sf = *(const LAS bf16x8*)(SB + (et * 16 + fr) * HS_LD + ks * 32 + fq * 8);
                accO = __builtin_amdgcn_mfma_f32_16x16x32_bf16(sf, qf, accO, 0, 0, 0);
                if (wid < 4) {
                    const bf16x8 kf = *(const LAS bf16x8*)(KT + (pjt * 16 + fr) * HS_LD + ks * 32 + fq * 8);
                    const bf16x8 qf2 = *(const LAS bf16x8*)(QT + (pit * 16 + fr) * HS_LD + ks * 32 + fq * 8);
                    accP = __builtin_amdgcn_mfma_f32_16x16x32_bf16(kf, qf2, accP, 0, 0, 0);
                }
            }
            if (wid < 4) {
                const int i = pit * 16 + fr, j0 = pjt * 16 + fq * 4;
                float pv[4];
#pragma unroll
                for (int r = 0; r < 4; ++r) pv[r] = (j0 + r <= i) ? accP[r] : 0.f;
                *(LAS u32x2*)(PP + i * HS_LD2 + j0) = (u32x2){cvtpk(pv[0], pv[1]), cvtpk(pv[2], pv[3])};
            }
        }
        __syncthreads();
        {
            const bf16x8 vf = *(const LAS bf16x8*)(VT + (et * 16 + fr) * HS_LD2 + fq * 8);
            const bf16x8 pf = *(const LAS bf16x8*)(PP + (it * 16 + fr) * HS_LD2 + fq * 8);
            accO = __builtin_amdgcn_mfma_f32_16x16x32_bf16(vf, pf, accO, 0, 0, 0);
            *(f32x4*)(OL + HS_ROW(c * 32 + it * 16 + fr) * 256 + hh * 64 + et * 16 + fq * 4) = accO;
            const f32x4 bd = *(const LAS f32x4*)(B31 + wid * 16 + fq * 4);
            const f32x4 dec = (f32x4){__expf(bd[0]), __expf(bd[1]), __expf(bd[2]), __expf(bd[3])};
            const bf16x8 kf = *(const LAS bf16x8*)(KHT + (wid * 16 + fr) * HS_LD2 + fq * 8);
#pragma unroll
            for (int e4 = 0; e4 < 4; ++e4) {
                const bf16x8 vf2 = *(const LAS bf16x8*)(VT + (e4 * 16 + fr) * HS_LD2 + fq * 8);
                accS[e4] = accS[e4] * dec;
                accS[e4] = __builtin_amdgcn_mfma_f32_16x16x32_bf16(kf, vf2, accS[e4], 0, 0, 0);
                *(LAS u32x2*)(SB + (e4 * 16 + fr) * HS_LD + wid * 16 + fq * 4) = (u32x2){cvtpk_c(accS[e4][0], accS[e4][1]), cvtpk_c(accS[e4][2], accS[e4][3])};
            }
        }
        __syncthreads();
    }
#undef HS_LOAD
#undef HS_ROW
    float* SL = WSP(float, WS_SLOC) + ((size_t)chain * NSEG + seg) * 8192;
#pragma unroll
    for (int e4 = 0; e4 < 4; ++e4)
#pragma unroll
        for (int r = 0; r < 4; ++r) SL[(wid * 16 + fq * 4 + r) * 64 + e4 * 16 + fr] = accS[e4][r];
    if (tq == 0) WSP(float, WS_DTOT)[((size_t)chain * NSEG + seg) * 128 + d] = B0;
}

constexpr int PU_LD = 264;
DI void pool_unit(const Frame& F, int l, int u) {
    const int tid = F.tid, lane = F.lane, wid = F.wid, fr = lane & 15, fq = lane >> 4;
    int b, t0, n; size_t rowbase;
    if (u < 256) { b = u >> 7; t0 = (u & 127) * 64; n = SEQ; rowbase = (size_t)b * SEQ; }
    else { const int uu = u - 256; b = uu >> 2; t0 = (uu & 3) * 64; n = CTX; rowbase = (size_t)NLAT + b * CTX; }
    LAS bf16_t* U = (LAS bf16_t*)F.lds;
    LAS bf16_t* PL = (LAS bf16_t*)(F.lds + 80 * PU_LD * 2);
    const bf16_t* PA = WSP(const bf16_t, WS_PA);
    __syncthreads();
    {
        u32x4 uv[5];
#pragma unroll
        for (int q = 0; q < 5; ++q) {
            const int i = tid + q * 512, r = i >> 5, c8 = (i & 31) * 8, t = t0 - 8 + r, tc = min(max(t, 0), n - 1);
            uv[q] = *(const u32x4*)(PA + (rowbase + tc) * 256 + c8);
        }
#pragma unroll
        for (int q = 0; q < 5; ++q) {
            const int i = tid + q * 512, r = i >> 5, c8 = (i & 31) * 8, t = t0 - 8 + r;
            *(LAS u32x4*)(U + r * PU_LD + c8) = (t >= 0 && t < n) ? uv[q] : (u32x4){0u, 0u, 0u, 0u};
        }
    }
    __syncthreads();
    {
        const int c = tid & 255, th = tid >> 8, gi = c >> 6, half = 1 << gi;
        int t = th * 32;
        float sacc = 0.f;
        for (int x = -half; x < half; ++x) sacc += bf2f(U[(t + 8 + x) * PU_LD + c]);
#pragma unroll 4
        for (int tt = 0; tt < 32; ++tt, ++t) {
            const int T = t0 + t;
            const int lo = max(T - half, 0), hi = min(T + half, n);
            const float cur = bf2f(U[(t + 8) * PU_LD + c]);
            PL[t * PU_LD + c] = (bf16_t)f2bf(sacc / (float)(hi - lo) - cur);
            sacc += bf2f(U[(t + 8 + half) * PU_LD + c]) - bf2f(U[(t + 8 - half) * PU_LD + c]);
        }
    }
    __syncthreads();
    {
        const int gi = wid >> 1, th = wid & 1;
        const bf16_t* WT = WSP(const bf16_t, WS_POOLWT) + ((size_t)l * 4 + gi) * 4096;
        const float* psc = inp(F, I_POOLS) + l * 256 + gi * 64;
        bf16_t* MX = WSP(bf16_t, WS_MIX);
#pragma unroll
        for (int mt = 0; mt < 2; ++mt) {
            bf16x8 af[2];
#pragma unroll
            for (int ks = 0; ks < 2; ++ks) af[ks] = *(const LAS bf16x8*)(PL + (th * 32 + mt * 16 + fr) * PU_LD + gi * 64 + ks * 32 + fq * 8);
            const size_t row = rowbase + t0 + th * 32 + mt * 16 + fr;
#pragma unroll
            for (int nt = 0; nt < 4; ++nt) {
                f32x4 acc = (f32x4){0.f, 0.f, 0.f, 0.f};
#pragma unroll
                for (int ks = 0; ks < 2; ++ks) {
                    const bf16x8 bfg = *(const bf16x8*)(WT + (nt * 16 + fr) * 64 + ks * 32 + fq * 8);
                    acc = __builtin_amdgcn_mfma_f32_16x16x32_bf16(bfg, af[ks], acc, 0, 0, 0);
                }
                const f32x4 sc4 = *(const f32x4*)(psc + nt * 16 + fq * 4);
                const f32x4 r4 = acc * sc4;
                *(u32x2*)(MX + row * 1024 + gi * 64 + nt * 16 + fq * 4) = (u32x2){cvtpk(r4[0], r4[1]), cvtpk(r4[2], r4[3])};
            }
        }
    }
}

DI void qproj_unit(const Frame& F, int u) {
    const int wid = F.wid, lane = F.lane, wr = wid >> 1, wc = wid & 1, fr = lane & 15, fq = lane >> 4;
    const int rt = u / 6, ct = u % 6;
    GemmTile g; g.A = WSP(const bf16_t, WS_CQKV); g.lda = 416; g.rowidx = nullptr; g.nvalid = 0; g.arow0 = (long)rt * 256;
    g.Bt = WSP(const bf16_t, WS_WUQ); g.ldb = 256; g.brow0 = (long)ct * 128; g.K = 256;
    f32x4 acc[4][4]; float ssq[4];
    gemm_tile<true>(F, g, acc, ssq);
    const float* rc = WSP(const float, WS_ROPE); const float* rs = rc + 8192 * 16;
    bf16_t* QB = WSP(bf16_t, WS_QB);
#pragma unroll
    for (int m = 0; m < 4; ++m) {
        const int row = rt * 256 + wr * 64 + m * 16 + fr;
        const float rn = rsqrtf(ssq[m] * (1.f / 256.f) + EPS) * (AT_SCALE * 1.4426950408889634f);
        int bb, key; bool lat = row < NLAT;
        if (lat) { bb = row >> 13; key = row & 8191; } else { bb = (row - NLAT) >> 8; key = SEQ + ((row - NLAT) & 255); }
#pragma unroll
        for (int n = 0; n < 4; ++n) {
            const int col = ct * 128 + wc * 64 + n * 16, hd = col / 96, dq0 = col - hd * 96;
            f32x4 v = acc[m][n] * rn;
            if (dq0 >= 64) {
                const int ax = (dq0 - 64) >> 4;
                f32x4 pv;
#pragma unroll
                for (int j = 0; j < 4; ++j) pv[j] = __shfl_xor(v[j], 32);
                if (lat) {
                    const int f0 = (fq & 1) * 4;
                    const f32x4 cs = *(const f32x4*)(rc + key * 16 + ax * 8 + f0), sn = *(const f32x4*)(rs + key * 16 + ax * 8 + f0);
                    if (fq < 2) v = v * cs - pv * sn; else v = v * cs + pv * sn;
                }
            }
            *(u32x2*)(QB + (((size_t)bb * 8 + hd) * NKEY + key) * 96 + dq0 + fq * 4) = (u32x2){cvtpk(v[0], v[1]), cvtpk(v[2], v[3])};
        }
    }
}

DI void kvproj_unit(const Frame& F, int l, int u) {
    const int tid = F.tid, wid = F.wid, lane = F.lane, wr = wid >> 1, wc = wid & 1, fr = lane & 15, fq = lane >> 4;
    const int rt = u >> 3, hd = u & 7;
    GemmTile g; g.A = WSP(const bf16_t, WS_CQKV) + 256; g.lda = 416; g.rowidx = nullptr; g.nvalid = 0; g.arow0 = (long)rt * 256;
    g.Bt = WSP(const bf16_t, WS_WUKV); g.ldb = 128; g.brow0 = (long)hd * 128; g.K = 128;
    f32x4 acc[4][4]; float ssq[4];
    gemm_tile<true>(F, g, acc, ssq);
    bf16_t* KB = WSP(bf16_t, WS_KB); bf16_t* VB = WSP(bf16_t, WS_VB);
    float nrm2[4] = {0.f, 0.f, 0.f, 0.f};
#pragma unroll
    for (int m = 0; m < 4; ++m) {
        const int row = rt * 256 + wr * 64 + m * 16 + fr;
        const float rn = rsqrtf(ssq[m] * (1.f / 128.f) + EPS);
        int bb, key;
        if (row < NLAT) { bb = row >> 13; key = row & 8191; } else { bb = (row - NLAT) >> 8; key = SEQ + ((row - NLAT) & 255); }
        const size_t kr = ((size_t)bb * 8 + hd) * NKEY + key;
#pragma unroll
        for (int n = 0; n < 4; ++n) {
            const int c = n * 16 + fq * 4;
            const f32x4 v = acc[m][n] * rn;
            const u32x2 pk = (u32x2){cvtpk(v[0], v[1]), cvtpk(v[2], v[3])};
            if (wc == 0) { *(u32x2*)(KB + kr * 128 + c) = pk; nrm2[m] += v[0] * v[0] + v[1] * v[1] + v[2] * v[2] + v[3] * v[3]; } else *(u32x2*)(VB + kr * 64 + c) = pk;
        }
    }
    unsigned* kmaxw = WSP(unsigned, WS_CTL) + CW_KMAX + (l * 16 + (rt < 64 ? (rt >> 5) : (rt - 64)) * 8 + hd) * 2;
    if (wc == 0) {
        float mx = 0.f;
#pragma unroll
        for (int m = 0; m < 4; ++m) { float t = nrm2[m]; t += __shfl_xor(t, 16); t += __shfl_xor(t, 32); mx = fmaxf(mx, t); }
#pragma unroll
        for (int o = 8; o >= 1; o >>= 1) mx = fmaxf(mx, __shfl_xor(mx, o));
        if (lane == 0) atomicMax(kmaxw, __float_as_uint(mx));
    }
    {
        const int row = rt * 256 + (tid >> 1), ax = tid & 1;
        const bf16_t* src = WSP(const bf16_t, WS_CQKV) + (size_t)row * 416 + 384 + ax * 16;
        const u32x4 a = *(const u32x4*)src, bq = *(const u32x4*)(src + 8);
        float x1[8], x2[8];
#pragma unroll
        for (int j = 0; j < 4; ++j) { x1[2 * j] = bf2f(a[j] & 0xffffu); x1[2 * j + 1] = bf2f(a[j] >> 16); x2[2 * j] = bf2f(bq[j] & 0xffffu); x2[2 * j + 1] = bf2f(bq[j] >> 16); }
        int bb, key; const bool lat = row < NLAT;
        if (lat) { bb = row >> 13; key = row & 8191; } else { bb = (row - NLAT) >> 8; key = SEQ + ((row - NLAT) & 255); }
        float o1[8], o2[8];
        if (lat) {
            const float* rc = WSP(const float, WS_ROPE) + key * 16 + ax * 8; const float* rs = rc + 8192 * 16;
#pragma unroll
            for (int f = 0; f < 8; ++f) { o1[f] = x1[f] * rc[f] - x2[f] * rs[f]; o2[f] = x2[f] * rc[f] + x1[f] * rs[f]; }
        } else {
#pragma unroll
            for (int f = 0; f < 8; ++f) { o1[f] = x1[f]; o2[f] = x2[f]; }
        }
        {
            float t = 0.f;
#pragma unroll
            for (int f = 0; f < 8; ++f) t += o1[f] * o1[f] + o2[f] * o2[f];
            t += __shfl_xor(t, 1);
#pragma unroll
            for (int o = 32; o >= 2; o >>= 1) t = fmaxf(t, __shfl_xor(t, o));
            if (lane == 0) atomicMax(kmaxw + 1, __float_as_uint(t));
        }
        bf16_t* dst = KB + (((size_t)bb * 8 + hd) * NKEY + key) * 128;
        *(u32x4*)(dst + 64 + ax * 16) = (u32x4){cvtpk(o1[0], o1[1]), cvtpk(o1[2], o1[3]), cvtpk(o1[4], o1[5]), cvtpk(o1[6], o1[7])};
        *(u32x4*)(dst + 64 + ax * 16 + 8) = (u32x4){cvtpk(o2[0], o2[1]), cvtpk(o2[2], o2[3]), cvtpk(o2[4], o2[5]), cvtpk(o2[6], o2[7])};
    }
}

DI void phase_local(const Frame& Fin, int l) {
    PHASE_FRAME(Fin);
    const int bid = F.bid;
    hgrn_scan_unit(F, (bid >> 4) * NSEG + 1 + (bid & 15));
    if (bid < 16) hgrn_scan_unit(F, bid * NSEG);
    __syncthreads();
    pool_unit(F, l, bid);
    if (bid >= 16 && bid < 24) pool_unit(F, l, 256 + bid - 16);
    __syncthreads();
    if (bid >= 24) {
        const int j = bid - 24;
        for (int u = j; u < 66 * 6; u += 232) qproj_unit(F, u);
        for (int u = j; u < 66 * 8; u += 232) kvproj_unit(F, l, u);
    }
}

constexpr int AT_SHM_V = 64 * 64 * 2, AT_SHM_K = 64 * 128 * 2;
constexpr float AT_THR = 8.f;
#define KSWZ(row, colB) ((row) * 256 + ((colB) ^ (((row) & 7) << 4)))
#define SBAR() __builtin_amdgcn_sched_barrier(0)
DI int crow(int r, int hi) { return (r & 3) + 8 * (r >> 2) + 4 * hi; }
DI void partialSM(f32x16& p0, f32x16& p1, bool shift, float mnC) {
    if (shift) {
#pragma unroll
        for (int r = 0; r < 16; ++r) { p0[r] += mnC; p1[r] += mnC; }
    }
#pragma unroll
    for (int r = 0; r < 16; ++r) p0[r] = __builtin_amdgcn_exp2f(p0[r]);
}
DI void finishSM(f32x16& p0, f32x16& p1, bf16x8& pa0, bf16x8& pa1, bf16x8& pa2, bf16x8& pa3) {
#pragma unroll
    for (int r = 0; r < 16; ++r) p1[r] = __builtin_amdgcn_exp2f(p1[r]);
#define PK4(P, BASE, OUT) do { unsigned a0 = cvtpk(P[BASE + 0], P[BASE + 1]), a1 = cvtpk(P[BASE + 2], P[BASE + 3]);   \
    unsigned b0 = cvtpk(P[BASE + 4], P[BASE + 5]), b1 = cvtpk(P[BASE + 6], P[BASE + 7]);                              \
    auto r0 = __builtin_amdgcn_permlane32_swap(a0, b0, false, false); auto r1 = __builtin_amdgcn_permlane32_swap(a1, b1, false, false); \
    u32x4 w = {r0[0], r1[0], r0[1], r1[1]}; OUT = __builtin_bit_cast(bf16x8, w); } while (0)
    PK4(p0, 0, pa0); PK4(p0, 8, pa1); PK4(p1, 0, pa2); PK4(p1, 8, pa3);
#undef PK4
}
DI void qkt(f32x16& p0, f32x16& p1, const LAS unsigned char* Ks, const bf16x8* qr, int r32, int hi) {
    const f32x16 z16 = {0.f, 0.f, 0.f, 0.f, 0.f, 0.f, 0.f, 0.f, 0.f, 0.f, 0.f, 0.f, 0.f, 0.f, 0.f, 0.f};
#pragma unroll
    for (int d0 = 0; d0 < 6; ++d0) { const int cb = (d0 * 16 + hi * 8) * 2;
        const bf16x8 b0 = *(const LAS bf16x8*)(Ks + KSWZ(r32, cb));
        const bf16x8 b1 = *(const LAS bf16x8*)(Ks + KSWZ(32 + r32, cb));
        if (d0 == 0) { p0 = __builtin_amdgcn_mfma_f32_32x32x16_bf16(b0, qr[d0], z16, 0, 0, 0); p1 = __builtin_amdgcn_mfma_f32_32x32x16_bf16(b1, qr[d0], z16, 0, 0, 0); }
        else { p0 = __builtin_amdgcn_mfma_f32_32x32x16_bf16(b0, qr[d0], p0, 0, 0, 0); p1 = __builtin_amdgcn_mfma_f32_32x32x16_bf16(b1, qr[d0], p1, 0, 0, 0); } }
}
DI int v_st(int k, int c) { const int kk = (k & ~0xC) | ((k & 4) << 1) | ((k & 8) >> 1); return ((kk >> 3) * 2 + (c >> 5)) * 512 + ((kk & 7) * 32 + (c & 31)) * 2; }
DI int v_rd_base(int lane) { return ((lane & 3) << 3) | (((lane >> 2) & 3) << 6) | (((lane >> 4) & 1) << 5) | (((lane >> 5) & 1) << 8); }
constexpr int v_rd_off(int d0, int ks, int half) { return d0 * 512 + ks * 2048 + half * 1024; }
template <int OFF> DI s16x4 tr_read(int vb) { s16x4 r; asm volatile("ds_read_b64_tr_b16 %0, %1 offset:%2" : "=&v"(r) : "v"(vb), "i"(OFF) : "memory"); return r; }
template <int D0> DI void pv_one(f32x16& od, int vb, bf16x8 pa0, bf16x8 pa1, bf16x8 pa2, bf16x8 pa3) {
    const s16x4 l0 = tr_read<v_rd_off(D0, 0, 0)>(vb), h0 = tr_read<v_rd_off(D0, 0, 1)>(vb), l1 = tr_read<v_rd_off(D0, 1, 0)>(vb), h1 = tr_read<v_rd_off(D0, 1, 1)>(vb);
    const s16x4 l2 = tr_read<v_rd_off(D0, 2, 0)>(vb), h2 = tr_read<v_rd_off(D0, 2, 1)>(vb), l3 = tr_read<v_rd_off(D0, 3, 0)>(vb), h3 = tr_read<v_rd_off(D0, 3, 1)>(vb);
    asm volatile("s_waitcnt lgkmcnt(0)" ::: "memory"); SBAR();
#define PKV(L, H) (bf16x8){L[0], L[1], L[2], L[3], H[0], H[1], H[2], H[3]}
    od = __builtin_amdgcn_mfma_f32_32x32x16_bf16(pa0, PKV(l0, h0), od, 0, 0, 0);
    od = __builtin_amdgcn_mfma_f32_32x32x16_bf16(pa1, PKV(l1, h1), od, 0, 0, 0);
    od = __builtin_amdgcn_mfma_f32_32x32x16_bf16(pa2, PKV(l2, h2), od, 0, 0, 0);
    od = __builtin_amdgcn_mfma_f32_32x32x16_bf16(pa3, PKV(l3, h3), od, 0, 0, 0);
#undef PKV
}
DI void pv_d0(f32x16* o, int vb, bf16x8 pa0, bf16x8 pa1, bf16x8 pa2, bf16x8 pa3) {
    pv_one<0>(o[0], vb, pa0, pa1, pa2, pa3); pv_one<1>(o[1], vb, pa0, pa1, pa2, pa3);
    const bf16x8 ones = (bf16x8){0x3F80, 0x3F80, 0x3F80, 0x3F80, 0x3F80, 0x3F80, 0x3F80, 0x3F80};
    o[2] = __builtin_amdgcn_mfma_f32_32x32x16_bf16(pa0, ones, o[2], 0, 0, 0);
    o[2] = __builtin_amdgcn_mfma_f32_32x32x16_bf16(pa1, ones, o[2], 0, 0, 0);
    o[2] = __builtin_amdgcn_mfma_f32_32x32x16_bf16(pa2, ones, o[2], 0, 0, 0);
    o[2] = __builtin_amdgcn_mfma_f32_32x32x16_bf16(pa3, ones, o[2], 0, 0, 0);
}
#define EX2(x) x = __builtin_amdgcn_exp2f(x)
#define PINB() __builtin_amdgcn_sched_barrier(0)
#define PERM2(A0, B0, A1, B1, OUT) do { auto r0_ = __builtin_amdgcn_permlane32_swap(A0, B0, false, false); auto r1_ = __builtin_amdgcn_permlane32_swap(A1, B1, false, false); \
    u32x4 w_ = {r0_[0], r1_[0], r0_[1], r1_[1]}; OUT = __builtin_bit_cast(bf16x8, w_); } while (0)
DI void att_region1(f32x16& n0, f32x16& n1, const LAS unsigned char* Ks, const bf16x8* qr, f32x16& p0, f32x16& p1, bf16x8& pa0, bf16x8& pa1, bf16x8& pa2, bf16x8& pa3, int r32, int hi) {
    const f32x16 z16 = {0.f, 0.f, 0.f, 0.f, 0.f, 0.f, 0.f, 0.f, 0.f, 0.f, 0.f, 0.f, 0.f, 0.f, 0.f, 0.f};
#define KFR(d0, half) (*(const LAS bf16x8*)(Ks + KSWZ(r32, ((d0) * 16 + hi * 8) * 2) + (half) * 8192))
    unsigned a0, a1, b0, b1, c0, c1, e0, e1;
    bf16x8 k0 = KFR(0, 0), k1 = KFR(0, 1), m0 = KFR(1, 0), m1 = KFR(1, 1);
    n0 = __builtin_amdgcn_mfma_f32_32x32x16_bf16(k0, qr[0], z16, 0, 0, 0); n1 = __builtin_amdgcn_mfma_f32_32x32x16_bf16(k1, qr[0], z16, 0, 0, 0);
    k0 = KFR(2, 0); k1 = KFR(2, 1);
    EX2(p1[0]); EX2(p1[1]); EX2(p1[2]);
    a0 = cvtpk_c(p0[0], p0[1]); a1 = cvtpk_c(p0[2], p0[3]); b0 = cvtpk_c(p0[4], p0[5]); b1 = cvtpk_c(p0[6], p0[7]);
    PINB();
    n0 = __builtin_amdgcn_mfma_f32_32x32x16_bf16(m0, qr[1], n0, 0, 0, 0); n1 = __builtin_amdgcn_mfma_f32_32x32x16_bf16(m1, qr[1], n1, 0, 0, 0);
    m0 = KFR(3, 0); m1 = KFR(3, 1);
    EX2(p1[3]); EX2(p1[4]); EX2(p1[5]);
    PERM2(a0, b0, a1, b1, pa0);
    c0 = cvtpk_c(p0[8], p0[9]); c1 = cvtpk_c(p0[10], p0[11]);
    PINB();
    n0 = __builtin_amdgcn_mfma_f32_32x32x16_bf16(k0, qr[2], n0, 0, 0, 0); n1 = __builtin_amdgcn_mfma_f32_32x32x16_bf16(k1, qr[2], n1, 0, 0, 0);
    k0 = KFR(4, 0); k1 = KFR(4, 1);
    EX2(p1[6]); EX2(p1[7]); EX2(p1[8]);
    e0 = cvtpk_c(p0[12], p0[13]); e1 = cvtpk_c(p0[14], p0[15]);
    PERM2(c0, e0, c1, e1, pa1);
    PINB();
    n0 = __builtin_amdgcn_mfma_f32_32x32x16_bf16(m0, qr[3], n0, 0, 0, 0); n1 = __builtin_amdgcn_mfma_f32_32x32x16_bf16(m1, qr[3], n1, 0, 0, 0);
    m0 = KFR(5, 0); m1 = KFR(5, 1);
    EX2(p1[9]); EX2(p1[10]); EX2(p1[11]);
    a0 = cvtpk_c(p1[0], p1[1]); a1 = cvtpk_c(p1[2], p1[3]); b0 = cvtpk_c(p1[4], p1[5]); b1 = cvtpk_c(p1[6], p1[7]);
    PINB();
    n0 = __builtin_amdgcn_mfma_f32_32x32x16_bf16(k0, qr[4], n0, 0, 0, 0); n1 = __builtin_amdgcn_mfma_f32_32x32x16_bf16(k1, qr[4], n1, 0, 0, 0);
    EX2(p1[12]); EX2(p1[13]); EX2(p1[14]);
    PERM2(a0, b0, a1, b1, pa2);
    c0 = cvtpk_c(p1[8], p1[9]); c1 = cvtpk_c(p1[10], p1[11]);
    PINB();
    n0 = __builtin_amdgcn_mfma_f32_32x32x16_bf16(m0, qr[5], n0, 0, 0, 0); n1 = __builtin_amdgcn_mfma_f32_32x32x16_bf16(m1, qr[5], n1, 0, 0, 0);
    EX2(p1[15]);
    e0 = cvtpk_c(p1[12], p1[13]); e1 = cvtpk_c(p1[14], p1[15]);
    PERM2(c0, e0, c1, e1, pa3);
    PINB();
#undef KFR
}
template <int KS> DI void att_vfrag(int vb, s16x4& l0, s16x4& h0, s16x4& l1, s16x4& h1) {
    l0 = tr_read<v_rd_off(0, KS, 0)>(vb); h0 = tr_read<v_rd_off(0, KS, 1)>(vb); l1 = tr_read<v_rd_off(1, KS, 0)>(vb); h1 = tr_read<v_rd_off(1, KS, 1)>(vb);
}
DI void att_region2(f32x16* o, int vb, bf16x8 pa0, bf16x8 pa1, bf16x8 pa2, bf16x8 pa3, f32x16& n0, f32x16& n1, bool shift, float mnC) {
    if (shift) {
#pragma unroll
        for (int r = 0; r < 16; ++r) { n0[r] += mnC; n1[r] += mnC; }
    }
    const bf16x8 ones = (bf16x8){0x3F80, 0x3F80, 0x3F80, 0x3F80, 0x3F80, 0x3F80, 0x3F80, 0x3F80};
#define PKV(L, H) (bf16x8){L[0], L[1], L[2], L[3], H[0], H[1], H[2], H[3]}
#define WAITL() do { asm volatile("s_waitcnt lgkmcnt(0)" ::: "memory"); PINB(); } while (0)
    s16x4 la, ha, lb, hb, lc, hc, ld, hd;
    att_vfrag<0>(vb, la, ha, lb, hb); WAITL();
    att_vfrag<1>(vb, lc, hc, ld, hd);
    o[0] = __builtin_amdgcn_mfma_f32_32x32x16_bf16(pa0, PKV(la, ha), o[0], 0, 0, 0); o[1] = __builtin_amdgcn_mfma_f32_32x32x16_bf16(pa0, PKV(lb, hb), o[1], 0, 0, 0);
    o[2] = __builtin_amdgcn_mfma_f32_32x32x16_bf16(pa0, ones, o[2], 0, 0, 0);
    EX2(n0[0]); EX2(n0[1]); EX2(n0[2]); EX2(n0[3]);
    WAITL();
    att_vfrag<2>(vb, la, ha, lb, hb);
    o[0] = __builtin_amdgcn_mfma_f32_32x32x16_bf16(pa1, PKV(lc, hc), o[0], 0, 0, 0); o[1] = __builtin_amdgcn_mfma_f32_32x32x16_bf16(pa1, PKV(ld, hd), o[1], 0, 0, 0);
    o[2] = __builtin_amdgcn_mfma_f32_32x32x16_bf16(pa1, ones, o[2], 0, 0, 0);
    EX2(n0[4]); EX2(n0[5]); EX2(n0[6]); EX2(n0[7]);
    WAITL();
    att_vfrag<3>(vb, lc, hc, ld, hd);
    o[0] = __builtin_amdgcn_mfma_f32_32x32x16_bf16(pa2, PKV(la, ha), o[0], 0, 0, 0); o[1] = __builtin_amdgcn_mfma_f32_32x32x16_bf16(pa2, PKV(lb, hb), o[1], 0, 0, 0);
    o[2] = __builtin_amdgcn_mfma_f32_32x32x16_bf16(pa2, ones, o[2], 0, 0, 0);
    EX2(n0[8]); EX2(n0[9]); EX2(n0[10]); EX2(n0[11]);
    WAITL();
    o[0] = __builtin_amdgcn_mfma_f32_32x32x16_bf16(pa3, PKV(lc, hc), o[0], 0, 0, 0); o[1] = __builtin_amdgcn_mfma_f32_32x32x16_bf16(pa3, PKV(ld, hd), o[1], 0, 0, 0);
    o[2] = __builtin_amdgcn_mfma_f32_32x32x16_bf16(pa3, ones, o[2], 0, 0, 0);
    EX2(n0[12]); EX2(n0[13]); EX2(n0[14]); EX2(n0[15]);
    PINB();
#undef PKV
#undef WAITL
}
DI void attn_unit(const Frame& F, const bf16_t* __restrict__ Qb, const bf16_t* __restrict__ Kh, const bf16_t* __restrict__ Vh, bf16_t* __restrict__ Ob, int seq, float kmax2) {
    const int tid = F.tid, wid = F.wid, lane = F.lane, r32 = lane & 31, hi = lane >> 5;
    LAS unsigned char* V_lds = F.lds; LAS unsigned char* K_lds = F.lds + 4 * AT_SHM_V;
    f32x16 o[3];
#pragma unroll
    for (int r = 0; r < 16; ++r) { o[0][r] = 0.f; o[1][r] = 0.f; o[2][r] = 0.f; }
    bf16x8 qr[6];
    const bf16_t* Qw = Qb + (size_t)(wid * 32 + r32) * 96 + hi * 8;
    float qn2 = 0.f;
#pragma unroll
    for (int d0 = 0; d0 < 6; ++d0) { qr[d0] = *(const bf16x8*)(Qw + d0 * 16);
#pragma unroll
        for (int j = 0; j < 8; ++j) { const float qv = bf2f((unsigned)(unsigned short)qr[d0][j]); qn2 = fmaf(qv, qv, qn2); } }
    qn2 += __shfl_xor(qn2, 32);
    const float mnC = -(sqrtf(qn2 * kmax2) * 1.02f + 1e-3f);
    const bool shift = __any(mnC < -96.f);
    const int vb0 = (int)(uintptr_t)V_lds + v_rd_base(lane);
    unsigned vsrc, ksrc0, ksrc1;
    { const int d = tid, sub = d >> 5, w = d & 31, kk = (sub >> 1) * 8 + (w >> 2), k = (kk & ~0xC) | ((kk & 4) << 1) | ((kk & 8) >> 1), c = (sub & 1) * 32 + (w & 3) * 8;
      vsrc = (unsigned)(k * 64 + c) * 2u;
      const int b0 = tid * 16, row0 = b0 >> 8, ch0 = (b0 >> 4) & 15; ksrc0 = (unsigned)(row0 * 256 + ((ch0 ^ (row0 & 7)) << 4)); ksrc1 = ksrc0 + 32u * 256u; }
    const unsigned ldsw = (unsigned)wid * 1024u;
#define AISSUE(t) do { const int s_ = (t) & 3; const char* Vt_ = (const char*)Vh + (size_t)(t) * 8192; const char* Kt_ = (const char*)Kh + (size_t)(t) * 16384; \
    __builtin_amdgcn_global_load_lds((const unsigned*)(Vt_ + vsrc), (LAS unsigned*)(V_lds + s_ * AT_SHM_V + ldsw), 16, 0, 0); \
    __builtin_amdgcn_global_load_lds((const unsigned*)(Kt_ + ksrc0), (LAS unsigned*)(K_lds + s_ * AT_SHM_K + ldsw), 16, 0, 0); \
    __builtin_amdgcn_global_load_lds((const unsigned*)(Kt_ + ksrc1), (LAS unsigned*)(K_lds + s_ * AT_SHM_K + 8192 + ldsw), 16, 0, 0); } while (0)
#define AWAITBAR(more) do { if (more) asm volatile("s_waitcnt vmcnt(3) lgkmcnt(0)" ::: "memory"); else asm volatile("s_waitcnt vmcnt(0) lgkmcnt(0)" ::: "memory"); __builtin_amdgcn_s_barrier(); } while (0)
    f32x16 pA0, pA1, pB0, pB1; bf16x8 pa0, pa1, pa2, pa3; const int NT = seq / 64;
    asm volatile("s_waitcnt vmcnt(0) lgkmcnt(0)" ::: "memory"); __builtin_amdgcn_s_barrier();
    AISSUE(0); AISSUE(1);
    AWAITBAR(true);
    AISSUE(2);
    qkt(pA0, pA1, K_lds, qr, r32, hi); partialSM(pA0, pA1, shift, mnC);
    AWAITBAR(true);
    for (int j = 1; j + 1 < NT; j += 2) {
        { const bool more = j + 2 < NT; if (more) AISSUE(j + 2); SBAR();
          att_region1(pB0, pB1, K_lds + (j & 3) * AT_SHM_K, qr, pA0, pA1, pa0, pa1, pa2, pa3, r32, hi);
          att_region2(o, vb0 + ((j - 1) & 3) * AT_SHM_V, pa0, pa1, pa2, pa3, pB0, pB1, shift, mnC);
          AWAITBAR(more); }
        { const bool more = j + 3 < NT; if (more) AISSUE(j + 3); SBAR();
          att_region1(pA0, pA1, K_lds + ((j + 1) & 3) * AT_SHM_K, qr, pB0, pB1, pa0, pa1, pa2, pa3, r32, hi);
          att_region2(o, vb0 + (j & 3) * AT_SHM_V, pa0, pa1, pa2, pa3, pA0, pA1, shift, mnC);
          AWAITBAR(more); }
    }
    SBAR(); qkt(pB0, pB1, K_lds + ((NT - 1) & 3) * AT_SHM_K, qr, r32, hi);
    finishSM(pA0, pA1, pa0, pa1, pa2, pa3); SBAR();
    pv_d0(o, vb0 + ((NT - 2) & 3) * AT_SHM_V, pa0, pa1, pa2, pa3); partialSM(pB0, pB1, shift, mnC);
    finishSM(pB0, pB1, pa0, pa1, pa2, pa3); SBAR();
    pv_d0(o, vb0 + ((NT - 1) & 3) * AT_SHM_V, pa0, pa1, pa2, pa3);
    {
        int lz = lane; asm volatile("" : "+v"(lz));
        const int r32z = lz & 31, hiz = lz >> 5;
        bf16_t* Ow = Ob + (size_t)(wid * 32) * 1024 + r32z;
#pragma unroll
        for (int r = 0; r < 16; ++r) { const int orow = crow(r, hiz); const float rl = __builtin_amdgcn_rcpf(o[2][r]);
#pragma unroll
            for (int d0 = 0; d0 < 2; ++d0) Ow[(size_t)orow * 1024 + d0 * 32] = (bf16_t)f2bf(o[d0][r] * rl); }
    }
#undef AISSUE
#undef AWAITBAR
}

constexpr int HF_LD = 264;
DI void hgrn_fix_unit(const Frame& F, int l, int u) {
    const int tid = F.tid, lane = F.lane, wid = F.wid, fr = lane & 15, fq = lane >> 4;
    int b, hh, seg, half;
    if (u < 256) { b = u >> 7; hh = (u >> 5) & 3; seg = 1 + ((u >> 1) & 15); half = u & 1; } else { b = (u - 256) >> 2; hh = (u - 256) & 3; seg = 0; half = 0; }
    LAS bf16_t* SIB = (LAS bf16_t*)F.lds;
    __syncthreads();
    if (seg != 0) {
        for (int dir = 0; dir < 2; ++dir) {
            const int chain = b * 8 + hh * 2 + dir;
            const int sseg = dir == 0 ? seg : NSEG - seg;
            const float* SL = WSP(const float, WS_SLOC) + (size_t)chain * NSEG * 8192;
            const float* DT = WSP(const float, WS_DTOT) + (size_t)chain * NSEG * 128;
            float a[16];
#pragma unroll
            for (int i = 0; i < 16; ++i) a[i] = 0.f;
#pragma unroll 2
            for (int j = 0; j < sseg; ++j) {
                float sv[16], dv[16];
#pragma unroll
                for (int i = 0; i < 16; ++i) { sv[i] = SL[(size_t)j * 8192 + tid + i * 512]; dv[i] = DT[j * 128 + (tid >> 6) + i * 8]; }
#pragma unroll
                for (int i = 0; i < 16; ++i) a[i] = fmaf(__expf(dv[i]), a[i], sv[i]);
            }
#pragma unroll
            for (int i = 0; i < 16; ++i) { const int idx = tid + i * 512, d = idx >> 6, e = idx & 63; SIB[e * HF_LD + dir * 128 + d] = (bf16_t)f2bf(a[i]); }
        }
    }
    __syncthreads();
    const int len = 256, t0 = seg == 0 ? 0 : (seg - 1) * 512 + half * 256;
    const size_t rowbase = seg == 0 ? (size_t)NLAT + b * CTX : (size_t)b * SEQ;
    const float* OL0 = WSP(const float, WS_OLOC); const float* OL1 = OL0 + (size_t)NTOK * 256;
    const bf16_t* QC0 = WSP(const bf16_t, WS_QCUM);
    for (int tile = wid; tile < (len >> 4); tile += 8) {
        const size_t row = rowbase + t0 + tile * 16 + fr;
        f32x4 acc[4];
#pragma unroll
        for (int et = 0; et < 4; ++et) acc[et] = (f32x4){0.f, 0.f, 0.f, 0.f};
        if (seg != 0) {
#pragma unroll
            for (int ks = 0; ks < 8; ++ks) {
                const bf16x8 qf = *(const bf16x8*)(QC0 + (size_t)(ks >> 2) * NTOK * 512 + row * 512 + hh * 128 + (ks & 3) * 32 + fq * 8);
#pragma unroll
                for (int et = 0; et < 4; ++et) {
                    const bf16x8 sf = *(const LAS bf16x8*)(SIB + (et * 16 + fr) * HF_LD + ks * 32 + fq * 8);
                    acc[et] = __builtin_amdgcn_mfma_f32_16x16x32_bf16(sf, qf, acc[et], 0, 0, 0);
                }
            }
        }
        float ss = 0.f;
#pragma unroll
        for (int et = 0; et < 4; ++et) {
            const f32x4 o0 = *(const f32x4*)(OL0 + row * 256 + hh * 64 + et * 16 + fq * 4), o1 = *(const f32x4*)(OL1 + row * 256 + hh * 64 + et * 16 + fq * 4);
            acc[et] = acc[et] + o0 + o1;
#pragma unroll
            for (int r = 0; r < 4; ++r) ss = fmaf(acc[et][r], acc[et][r], ss);
        }
        ss += __shfl_xor(ss, 16); ss += __shfl_xor(ss, 32);
        const float rs = rsqrtf(ss * (1.f / 64.f) + EPS);
#pragma unroll
        for (int et = 0; et < 4; ++et) {
            const int e0 = hh * 64 + et * 16 + fq * 4;
            const f32x4 ng = *(const f32x4*)(inp(F, I_HGNG) + l * 256 + e0);
            const u32x2 gt = *(const u32x2*)(WSP(const bf16_t, WS_GATE) + row * 256 + e0);
            const float g0 = bf2f(gt[0] & 0xffffu), g1 = bf2f(gt[0] >> 16), g2 = bf2f(gt[1] & 0xffffu), g3 = bf2f(gt[1] >> 16);
            *(u32x2*)(WSP(bf16_t, WS_MIX) + row * 1024 + 256 + e0) = (u32x2){cvtpk(acc[et][0] * rs * ng[0] * g0, acc[et][1] * rs * ng[1] * g1), cvtpk(acc[et][2] * rs * ng[2] * g2, acc[et][3] * rs * ng[3] * g3)};
        }
    }
}

DI void phase_attn(const Frame& Fin, int l) {
    PHASE_FRAME(Fin);
    {
        const int xcd = F.bid & 7, j = F.bid >> 3;
        for (int i = 0; i < 2; ++i) {
            const int bh = xcd * 2 + i, qb = j, b = bh >> 3, hd = bh & 7;
            const size_t kv0 = (size_t)bh * NKEY;
            const unsigned* kmw = WSP(const unsigned, WS_CTL) + CW_KMAX + (l * 16 + bh) * 2;
            attn_unit(F, WSP(const bf16_t, WS_QB) + (kv0 + qb * 256) * 96, WSP(const bf16_t, WS_KB) + kv0 * 128, WSP(const bf16_t, WS_VB) + kv0 * 64,
                      WSP(bf16_t, WS_MIX) + ((size_t)b * SEQ + qb * 256) * 1024 + 512 + hd * 64, NKEY, __uint_as_float(kmw[0]) + __uint_as_float(kmw[1]));
        }
        if (F.bid >= 240) {
            const int bh = F.bid - 240, b = bh >> 3, hd = bh & 7;
            const size_t kv0 = (size_t)bh * NKEY + SEQ;
            const unsigned* kmw = WSP(const unsigned, WS_CTL) + CW_KMAX + (l * 16 + bh) * 2;
            attn_unit(F, WSP(const bf16_t, WS_QB) + kv0 * 96, WSP(const bf16_t, WS_KB) + kv0 * 128, WSP(const bf16_t, WS_VB) + kv0 * 64,
                      WSP(bf16_t, WS_MIX) + ((size_t)NLAT + b * CTX) * 1024 + 512 + hd * 64, CTX, __uint_as_float(kmw[0]) + __uint_as_float(kmw[1]));
        }
    }
    __syncthreads();
    { PHASE_FRAME2(F); for (int u = F2.bid; u < 264; u += F2.G) hgrn_fix_unit(F2, l, u); }
}

struct EpiWout {
    Frame F;
    DI void operator()(const f32x4 (&acc)[2][2][4][2], const g8::Unit& u, int wr, int wc, int fr, int fq) const {
#pragma unroll
        for (int bj = 0; bj < 2; ++bj) { FOR_AMN { *(f32x4*)(WSP(float, WS_M) + ROW_ * 1024 + u.pn * 256 + bj * 128 + wc * 32 + n * 16 + fq * 4) = acc[ai][bj][m][n]; } }
    }
};
DI void phase_wout(const Frame& Fin) {
    PHASE_FRAME(Fin);
    g8::DenseSched S; S.init(NTOK, 1024, 1024, F.G, F.bid, WSP(const bf16_t, WS_MIX), WSP(const bf16_t, WS_WOUT));
    EpiWout E; E.F = F;
    g8::gemm8<false>(F, 1024, S, E);
}

DI void phase_ln1_router(const Frame& Fin, int l, int rep = 0) {
    PHASE_FRAME(Fin);
    const int tid = F.tid, lane = F.lane;
    LAS float* RW = (LAS float*)F.lds;
    __syncthreads();
    {
        f32x4 ew[16], gw[2];
        const float* REW = inp(F, I_REW) + (size_t)l * 32768; const float* RGW = inp(F, I_RGW) + (size_t)l * 4096;
#pragma unroll
        for (int n = 0; n < 16; ++n) ew[n] = *(const f32x4*)(REW + (size_t)(tid + n * 512) * 4);
#pragma unroll
        for (int n = 0; n < 2; ++n) gw[n] = *(const f32x4*)(RGW + (size_t)(tid + n * 512) * 4);
#pragma unroll
        for (int n = 0; n < 16; ++n) { const int q = tid + n * 512, k = q >> 3, c4 = (q & 7) * 4;
#pragma unroll
            for (int j = 0; j < 4; ++j) RW[(4 + c4 + j) * 1024 + k] = ew[n][j]; }
#pragma unroll
        for (int n = 0; n < 2; ++n) { const int k = tid + n * 512;
#pragma unroll
            for (int j = 0; j < 4; ++j) RW[j * 1024 + k] = gw[n][j]; }
    }
    __syncthreads();
    unsigned* cnt = WSP(unsigned, WS_CTL) + CW_CNT + l * 32 * 64;
    float a1[16], b1[16];
    row_load(inp(F, I_LN1G) + l * 1024, lane, a1); row_load(inp(F, I_LN1B) + l * 1024, lane, b1);
    for (int grp = F.bid * 8 + F.wid; grp < NTOK / 3; grp += F.G * 8) {
        float v[3][16];
#pragma unroll
        for (int r = 0; r < 3; ++r) {
            const int row = grp * 3 + r;
            const float* md = WSP(const float, WS_MOD) + (size_t)(l * 3 + row_seq(row)) * 6144;
            float t[16], g1[16];
            row_load(x_in_row(F, l, row), lane, v[r]);
            row_load(WSP(const float, WS_M) + (size_t)row * DM, lane, t);
            row_load(md + 2048, lane, g1);
#pragma unroll
            for (int i = 0; i < 16; ++i) v[r][i] = fmaf(ALPHA, v[r][i], g1[i] * t[i]);
        }
#pragma unroll
        for (int r = 0; r < 3; ++r) {
            const int row = grp * 3 + r;
            const float* md = WSP(const float, WS_MOD) + (size_t)(l * 3 + row_seq(row)) * 6144;
            row_ln(v[r]);
#pragma unroll
            for (int i = 0; i < 16; ++i) v[r][i] = fmaf(v[r][i], a1[i], b1[i]);
            row_store(WSP(float, WS_X1) + (size_t)row * DM, lane, v[r]);
            row_ln(v[r]);
            float sh[16], sc[16]; row_load(md + 3072, lane, sh); row_load(md + 4096, lane, sc);
#pragma unroll
            for (int i = 0; i < 16; ++i) v[r][i] = fmaf(v[r][i], 1.f + sc[i], sh[i]);
            row_store_bf16(WSP(bf16_t, WS_H) + (size_t)row * DM, lane, v[r]);
        }
        float mylg[3] = {0.f, 0.f, 0.f};
#pragma unroll 4
        for (int c = 0; c < 36; ++c) {
            f32x4 w[4];
#pragma unroll
            for (int i = 0; i < 4; ++i) w[i] = *(const LAS f32x4*)(RW + c * 1024 + lane * 4 + i * 256);
#pragma unroll
            for (int r = 0; r < 3; ++r) {
                float sacc = 0.f;
#pragma unroll
                for (int i = 0; i < 4; ++i) { sacc = fmaf(v[r][4 * i], w[i][0], sacc); sacc = fmaf(v[r][4 * i + 1], w[i][1], sacc); sacc = fmaf(v[r][4 * i + 2], w[i][2], sacc); sacc = fmaf(v[r][4 * i + 3], w[i][3], sacc); }
                sacc = wave_sum(sacc);
                mylg[r] = (lane == c) ? sacc : mylg[r];
            }
        }
        if (rep == 0) {
#pragma unroll
            for (int r = 0; r < 3; ++r) {
                const int row = grp * 3 + r;
                float g[4]; int gs = 0;
#pragma unroll
                for (int c = 0; c < 4; ++c) g[c] = __uint_as_float(__builtin_amdgcn_readlane(__float_as_uint(mylg[r]), c)) + inp(F, I_RGB)[l * 4 + c];
                float gm = g[0];
#pragma unroll
                for (int c = 1; c < 4; ++c) if (g[c] > gm) { gm = g[c]; gs = c; }
                float se = 0.f;
#pragma unroll
                for (int c = 0; c < 4; ++c) se += expf(g[c] - gm);
                const float wg = 1.f / se;
                float e[8];
#pragma unroll
                for (int c = 0; c < 8; ++c) e[c] = __uint_as_float(__builtin_amdgcn_readlane(__float_as_uint(mylg[r]), 4 + gs * 8 + c)) + inp(F, I_REB)[l * 32 + gs * 8 + c];
                int i0 = 0; float v0 = e[0];
#pragma unroll
                for (int c = 1; c < 8; ++c) if (e[c] > v0) { v0 = e[c]; i0 = c; }
                int i1 = -1; float v1 = -3.0e38f;
#pragma unroll
                for (int c = 0; c < 8; ++c) if (c != i0 && e[c] > v1) { v1 = e[c]; i1 = c; }
                const float p1 = expf(v1 - v0), den = 1.f / (1.f + p1);
                const float w0 = den * wg, w1 = p1 * den * wg;
                const int e0 = gs * 8 + i0, e1 = gs * 8 + i1;
                if (lane == 0) {
                    const unsigned pos0 = atomicAdd(&cnt[e0 * 64], 1u), pos1 = atomicAdd(&cnt[e1 * 64], 1u);
                    WSP(int, WS_LIST)[(size_t)e0 * NTOK + pos0] = row; WSP(float, WS_LISTW)[(size_t)e0 * NTOK + pos0] = w0;
                    WSP(int, WS_LIST)[(size_t)e1 * NTOK + pos1] = row; WSP(float, WS_LISTW)[(size_t)e1 * NTOK + pos1] = w1;
                    int* ts = WSP(int, WS_TOKSLOT) + (size_t)row * 4; ts[0] = e0; ts[1] = (int)pos0; ts[2] = e1; ts[3] = (int)pos1;
                }
            }
        }
    }
}

DI void moe_bases(const Frame& F, int l, LAS int* base  , LAS int* cnts  ) {
    __syncthreads();
    if (F.tid == 0) {
        const unsigned* cnt = WSP(const unsigned, WS_CTL) + CW_CNT + l * 32 * 64;
        int a = 0;
        for (int e = 0; e < 32; ++e) { const int c = (int)cnt[e * 64]; cnts[e] = c; base[e] = a; a += (c + 255) / 256 * 256; }
        base[32] = a;
    }
    __syncthreads();
}

struct MoeSched {
    LAS const int* base; LAS const int* cnts; int ntile, nN, G, c; const char* A; const char* B; size_t estepB, tstepB, tstepA; const int* list; bool gather;
    DI bool next(int i, g8::Unit& u) const {
        const long L = (long)i * G + c; if (L >= (long)ntile * nN) return false;
        const int rt = (int)(L / nN), ct = (int)(L % nN), slot0 = rt * 256;
        int e = 0;
        for (int q = 1; q < 32; ++q) if (slot0 >= base[q]) e = q;
        const int pos0 = slot0 - base[e];
        u.pm = rt; u.pn = ct; u.B = B + (size_t)e * estepB + (size_t)ct * tstepB;
        if (gather) { u.A = A; u.rowidx = list + (size_t)e * NTOK + pos0; u.nvalid = cnts[e] - pos0; }
        else { u.A = A + (size_t)rt * tstepA; u.rowidx = nullptr; u.nvalid = e * 65536 + 0; }
        return true;
    }
};
struct EpiMoeUp {
    Frame F;
    DI void operator()(const f32x4 (&acc)[2][2][4][2], const g8::Unit& u, int wr, int wc, int fr, int fq) const {
        bf16_t* ACT = WSP(bf16_t, WS_ACT);
#pragma unroll
        for (int bj = 0; bj < 2; ++bj) {
            const int hc = 16 * ((u.pn * 256 + bj * 128 + wc * 32) / 32) + fq * 4;
#pragma unroll
            for (int ai = 0; ai < 2; ++ai)
#pragma unroll
                for (int m = 0; m < 4; ++m) {
                    const f32x4 a = acc[ai][bj][m][0], bq = acc[ai][bj][m][1];
                    *(u32x2*)(ACT + ROW_ * 512 + hc) = (u32x2){cvtpk(silu_f(a[0]) * bq[0], silu_f(a[1]) * bq[1]), cvtpk(silu_f(a[2]) * bq[2], silu_f(a[3]) * bq[3])};
                }
        }
    }
};
DI void phase_moe_up(const Frame& Fin, int l) {
    PHASE_FRAME(Fin);
    LAS int* base = (LAS int*)(F.lds + LDS_MAIN + 64); LAS int* cnts = base + 40;
    moe_bases(F, l, base, cnts);
    MoeSched S; S.base = base; S.cnts = cnts; S.ntile = base[32] / 256; S.nN = 4; S.G = F.G; S.c = F.bid; S.A = (const char*)WSP(const bf16_t, WS_H); S.B = (const char*)WSP(const bf16_t, WS_W13);
    S.estepB = (size_t)1024 * 1024 * 2; S.tstepB = (size_t)256 * 1024 * 2; S.tstepA = 0; S.list = WSP(const int, WS_LIST); S.gather = true;
    EpiMoeUp E; E.F = F;
    g8::gemm8<true>(F, 1024, S, E);
}
struct EpiMoeDown {
    Frame F; LAS const int* base; LAS const int* cnts;
    DI void operator()(const f32x4 (&acc)[2][2][4][2], const g8::Unit& u, int wr, int wc, int fr, int fq) const {
        bf16_t* Y = WSP(bf16_t, WS_Y);
        const int e = u.nvalid >> 16, pos0 = u.pm * 256 - base[e], ce = cnts[e];
#pragma unroll
        for (int ai = 0; ai < 2; ++ai)
#pragma unroll
            for (int m = 0; m < 4; ++m) {
                const int pos = pos0 + ai * 128 + wr * 64 + m * 16 + fr;
                const float w = pos < ce ? WSP(const float, WS_LISTW)[(size_t)e * NTOK + pos] : 0.f;
#pragma unroll
                for (int bj = 0; bj < 2; ++bj)
#pragma unroll
                    for (int n = 0; n < 2; ++n) { const f32x4 v = acc[ai][bj][m][n] * w;
                        *(u32x2*)(Y + ROW_ * 1024 + u.pn * 256 + bj * 128 + wc * 32 + n * 16 + fq * 4) = PKV2(v); }
            }
    }
};
DI void phase_moe_down(const Frame& Fin, int l) {
    PHASE_FRAME(Fin);
    LAS int* base = (LAS int*)(F.lds + LDS_MAIN + 64); LAS int* cnts = base + 40;
    moe_bases(F, l, base, cnts);
    MoeSched S; S.base = base; S.cnts = cnts; S.ntile = base[32] / 256; S.nN = 4; S.G = F.G; S.c = F.bid; S.A = (const char*)WSP(const bf16_t, WS_ACT); S.B = (const char*)WSP(const bf16_t, WS_W2);
    S.estepB = (size_t)1024 * 512 * 2; S.tstepB = (size_t)256 * 512 * 2; S.tstepA = (size_t)256 * 512 * 2; S.list = nullptr; S.gather = false;
    EpiMoeDown E; E.F = F; E.base = base; E.cnts = cnts;
    g8::gemm8<false>(F, 512, S, E);
}

DI void row_load_bf16(const bf16_t* p, int lane, float (&v)[16]) {
#pragma unroll
    for (int i = 0; i < 4; ++i) { const u32x2 t = *(const u32x2*)(p + lane * 4 + i * 256); v[4 * i] = bf2f(t[0] & 0xffffu); v[4 * i + 1] = bf2f(t[0] >> 16); v[4 * i + 2] = bf2f(t[1] & 0xffffu); v[4 * i + 3] = bf2f(t[1] >> 16); }
}
DI void phase_ln2(const Frame& Fin, int l) {
    PHASE_FRAME(Fin);
    const int lane = F.lane;
    LAS int* base = (LAS int*)(F.lds + LDS_MAIN + 64); LAS int* cnts = base + 40;
    moe_bases(F, l, base, cnts);
    float a2[16], b2[16];
    row_load(inp(F, I_LN2G) + l * 1024, lane, a2); row_load(inp(F, I_LN2B) + l * 1024, lane, b2);
    const int nrow = (l == 3) ? NLAT : NTOK;
    for (int grp = F.bid * 8 + F.wid; grp * 3 < nrow; grp += F.G * 8) {
        float v[3][16];
#pragma unroll
        for (int r = 0; r < 3; ++r) {
            const int row = min(grp * 3 + r, nrow - 1);
            const float* md = WSP(const float, WS_MOD) + (size_t)(l * 3 + row_seq(row)) * 6144;
            const int* ts = WSP(const int, WS_TOKSLOT) + (size_t)row * 4;
            const size_t s0 = (size_t)base[ts[0]] + ts[1], s1 = (size_t)base[ts[2]] + ts[3];
            float y0[16], y1[16], g2[16];
            row_load(WSP(const float, WS_X1) + (size_t)row * DM, lane, v[r]);
            row_load_bf16(WSP(const bf16_t, WS_Y) + s0 * 1024, lane, y0);
            row_load_bf16(WSP(const bf16_t, WS_Y) + s1 * 1024, lane, y1);
            row_load(md + 5120, lane, g2);
#pragma unroll
            for (int i = 0; i < 16; ++i) v[r][i] = fmaf(ALPHA, v[r][i], g2[i] * (y0[i] + y1[i]));
        }
#pragma unroll
        for (int r = 0; r < 3; ++r) {
            const int row = grp * 3 + r;
            row_ln(v[r]);
#pragma unroll
            for (int i = 0; i < 16; ++i) v[r][i] = fmaf(v[r][i], a2[i], b2[i]);
            if (row < nrow) {
                if (l == 3) row_store((float*)(F.out + (size_t)row * DM), lane, v[r]);
                else row_store(WSP(float, WS_X) + (size_t)row * DM, lane, v[r]);
            }
        }
        if (l < 3) {
#pragma unroll
            for (int r = 0; r < 3; ++r) {
                const int row = grp * 3 + r;
                row_ln(v[r]);
                const float* md2 = WSP(const float, WS_MOD) + (size_t)((l + 1) * 3 + row_seq(min(row, nrow - 1))) * 6144;
                float sh[16], sc[16]; row_load(md2, lane, sh); row_load(md2 + 1024, lane, sc);
#pragma unroll
                for (int i = 0; i < 16; ++i) v[r][i] = fmaf(v[r][i], 1.f + sc[i], sh[i]);
                if (row < nrow) row_store_bf16(WSP(bf16_t, WS_H) + (size_t)row * DM, lane, v[r]);
            }
        }
    }
    if (l < 3) { __syncthreads(); phase_convert(F, l + 1); }
}

constexpr int N_STEPS = 2 + 4 * 8;
__global__ void __launch_bounds__(512, 2) mega(Params P) {
    extern __shared__ __attribute__((aligned(16))) unsigned char lds_raw[];
    Frame F;
    F.in = (kin_t)__builtin_amdgcn_kernarg_segment_ptr();
    F.out = (GAS float*)P.out; F.ws = (GAS unsigned char*)P.ws; F.lds = (LAS unsigned char*)lds_raw;
    F.tid = threadIdx.x; F.lane = F.tid & 63; F.wid = __builtin_amdgcn_readfirstlane(F.tid >> 6); F.G = gridDim.x; F.bid = blockIdx.x;
    const int s_lo = P.s_lo, s_hi = P.s_hi;
    if (F.tid < 64) ((LAS unsigned*)(F.lds + LDS_MAIN))[F.tid] = 0u;
    __syncthreads();
    XcdBarrier bar; bar.bar = WSP(unsigned, WS_CTL) + CW_BAR; bar.x = 0; bar.st = (volatile LAS unsigned*)(F.lds + LDS_MAIN);
    if (s_hi - s_lo > 1) bar = xcd_barrier_post(WSP(unsigned, WS_CTL) + CW_BAR, (volatile LAS unsigned*)(F.lds + LDS_MAIN));
#if defined(EXCL_PH)
#define PH_ON(k) ((k) != EXCL_PH)
#elif !defined(ONLY_PH)
#define PH_ON(k) true
#else
#define PH_ON(k) ((k) == ONLY_PH)
#endif
#ifndef DUP_PH
#define DUP_PH -1
#endif
#define REPS(k) int reps_ = 1 + ((k) == DUP_PH ? 1 : 0); asm volatile("" : "+s"(reps_)); _Pragma("unroll 1") for (int rep_ = 0; rep_ < reps_; ++rep_)
#define STEP(s) (s_lo <= (s) && (s) < s_hi)
#define SEAM(s) do { if (STEP(s) && STEP((s) + 1)) xcd_barrier(bar); } while (0)
    if (STEP(0) && PH_ON(0)) { REPS(0) phase_setup(F); }
    SEAM(0);
    if (STEP(1) && PH_ON(1)) { REPS(1) phase_mod0(F); }
    SEAM(1);
#pragma unroll 1
    for (int l = 0; l < 4; ++l) {
        const int sb = 2 + l * 8;
        if (STEP(sb + 0) && PH_ON(2)) { REPS(2) phase_proj(F, l); }
        SEAM(sb + 0);
        if (STEP(sb + 1) && PH_ON(3)) { REPS(3) phase_local(F, l); }
        SEAM(sb + 1);
        if (STEP(sb + 2) && PH_ON(4)) { REPS(4) phase_attn(F, l); }
        SEAM(sb + 2);
        if (STEP(sb + 3) && PH_ON(5)) { REPS(5) phase_wout(F); }
        SEAM(sb + 3);
        if (STEP(sb + 4) && PH_ON(6)) { REPS(6) phase_ln1_router(F, l, rep_); }
        SEAM(sb + 4);
        if (STEP(sb + 5) && PH_ON(7)) { REPS(7) phase_moe_up(F, l); }
        SEAM(sb + 5);
        if (STEP(sb + 6) && PH_ON(8)) { REPS(8) phase_moe_down(F, l); }
        SEAM(sb + 6);
        if (STEP(sb + 7) && PH_ON(9)) { REPS(9) phase_ln2(F, l); }
        SEAM(sb + 7);
    }
}

extern "C" void kernel_launch(void* const* d_in, const int* in_sizes, int n_in, void* d_out, int out_size, void* d_ws, size_t ws_size, hipStream_t stream) {
    static int grid = 0;
    if (grid == 0) {
        if (n_in != 27 || out_size != NLAT * DM || ws_size < WS_END) {
            fprintf(stderr, "kernel_launch: shape mismatch: n_in %d out %d ws %zu (need %zu)\n", n_in, out_size, ws_size, (size_t)WS_END); grid = -1; return; }
        int dev = 0, cus = 0, per_cu = 0;
        if (hipGetDevice(&dev) != hipSuccess || hipDeviceGetAttribute(&cus, hipDeviceAttributeMultiprocessorCount, dev) != hipSuccess) { grid = -1; return; }
        if (hipFuncSetAttribute((const void*)mega, hipFuncAttributeMaxDynamicSharedMemorySize, LDS_BYTES) != hipSuccess) { fprintf(stderr, "kernel_launch: hipFuncSetAttribute failed\n"); grid = -1; return; }
        if (hipOccupancyMaxActiveBlocksPerMultiprocessor(&per_cu, (const void*)mega, 512, LDS_BYTES) != hipSuccess || per_cu < 1) fprintf(stderr, "kernel_launch: occupancy query says %d\n", per_cu);
        (void)hipGetLastError();
        if (cus != 256) { fprintf(stderr, "kernel_launch: built for 256 CUs, found %d\n", cus); grid = -1; return; }
        grid = cus;
    }
    if (grid < 0) return;
    if (hipMemsetAsync((char*)d_ws + WS_CTL, 0, CTL_BYTES, stream) != hipSuccess) return;
    Params p{};
    for (int i = 0; i < 27; ++i) p.in[i] = (const float*)d_in[i];
    p.out = (float*)d_out; p.ws = (unsigned char*)d_ws;
#if MK_MULTI
    for (int s = 0; s < N_STEPS; ++s) { p.s_lo = s; p.s_hi = s + 1; hipLaunchKernelGGL(mega, dim3(grid), dim3(512), LDS_BYTES, stream, p); }
#else
    p.s_lo = 0; p.s_hi = N_STEPS;
    hipLaunchKernelGGL(mega, dim3(grid), dim3(512), LDS_BYTES, stream, p);
#endif
    const hipError_t le = hipPeekAtLastError();
    if (le != hipSuccess) fprintf(stderr, "kernel_launch: launch failed: %s\n", hipGetErrorName(le));
}
```
